# Optimizing an MI355X kernel written in HIP

```python
import jax, jax.numpy as jnp
from jax import lax
import numpy as np

D_MODEL = 1024
BATCH = 1
SEQ = 16384
DEPTH = 4

N_A_LAYERS = DEPTH // 2
N_B_LAYERS = DEPTH - N_A_LAYERS
D_FF = 4 * D_MODEL
NORM_EPS = 1e-6
NEG_INF = -1e30
GATE_FLOOR = 1e-30

HG_EXPAND = 128
HG_HEADS = D_MODEL // HG_EXPAND
HG_DK = HG_EXPAND
HG_DV = D_MODEL // HG_HEADS
HG_CHUNK = 64

NSA_HEADS = 16
NSA_KV_HEADS = 4
NSA_GROUP = NSA_HEADS // NSA_KV_HEADS
NSA_DH = D_MODEL // NSA_HEADS
CMP_BLOCK = 32
CMP_STRIDE = 16
CMP_HIDDEN = 4 * NSA_DH
SLC_BLOCK = 64
SLC_TOPK = 16
WINDOW = 512
Q_BLOCK = 128
FORCE_BONUS = 1e4
N_KV_STREAMS = 6

kernel_name = 'hgrn2_nsa_yoco_hybrid'


def rmsnorm(x, w):
    xf = x.astype(jnp.float32)
    y = xf * lax.rsqrt(jnp.mean(jnp.square(xf), axis=-1, keepdims=True) + NORM_EPS)
    return (y * w.astype(jnp.float32)).astype(x.dtype)


def squared_relu_mlp(h, w_up, w_down):
    return jnp.square(jax.nn.relu(h @ w_up)) @ w_down


def hgrn2_lower_bounds(lb_param):
    p = jax.nn.softmax(lb_param.astype(jnp.float32), axis=0)
    return jnp.cumsum(p, axis=0) - p[0:1]


def alibi_slopes(n):
    return jnp.exp2(-8.0 * jnp.arange(1, n + 1, dtype=jnp.float32) / n)


def masked_softmax(s, mask):
    p = jax.nn.softmax(jnp.where(mask, s, NEG_INF), axis=-1)
    return jnp.where(mask, p, 0.0)


def hgrn2_mixer(h, w_in, gnorm_w, w_out, lb):
    B, T, _ = h.shape
    hk = HG_HEADS * HG_DK
    hv = HG_HEADS * HG_DV
    proj = h @ w_in
    q = proj[..., :hk]
    f_pre = proj[..., hk:2 * hk].astype(jnp.float32)
    v_in = proj[..., 2 * hk:2 * hk + hv]
    g_out = proj[..., 2 * hk + hv:]
    f_gate = lb + (1.0 - lb) * jax.nn.sigmoid(f_pre)
    log_f = jnp.log(jnp.maximum(f_gate, GATE_FLOOR))
    k_in = (1.0 - lb) * jax.nn.sigmoid(-f_pre)
    nc = T // HG_CHUNK

    def chunks(t, d):
        return t.astype(jnp.float32).reshape(B, nc, HG_CHUNK, HG_HEADS, d).transpose(1, 0, 3, 2, 4)

    qc, kc, vc, gc = chunks(q, HG_DK), chunks(k_in, HG_DK), chunks(v_in, HG_DV), chunks(log_f, HG_DK)
    causal = jnp.tril(jnp.ones((HG_CHUNK, HG_CHUNK), dtype=bool))[None, None, :, :, None]

    def step(S, inp):
        qb, kb, vb, gb = inp
        bcum = jnp.cumsum(gb, axis=2)
        diff = bcum[:, :, :, None, :] - bcum[:, :, None, :, :]
        decay = jnp.exp(jnp.where(causal, diff, NEG_INF))
        attn = jnp.einsum('bhtd,bhsd,bhtsd->bhts', qb, kb, decay)
        o = (jnp.einsum('bhts,bhsv->bhtv', attn, vb)
             + jnp.einsum('bhtd,bhdv->bhtv', qb * jnp.exp(bcum), S))
        blast = bcum[:, :, -1:, :]
        S = (jnp.exp(blast[:, :, 0, :])[..., None] * S
             + jnp.einsum('bhsd,bhsv->bhdv', kb * jnp.exp(blast - bcum), vb))
        return S, o

    S0 = jnp.zeros((B, HG_HEADS, HG_DK, HG_DV), jnp.float32)
    _, o = lax.scan(step, S0, (qc, kc, vc, gc))
    o = o.transpose(1, 0, 3, 2, 4).reshape(B, T, HG_HEADS, HG_DV)
    o = rmsnorm(o, gnorm_w).reshape(B, T, hv) * jax.nn.silu(g_out.astype(jnp.float32))
    return o.astype(h.dtype) @ w_out


def compress_blocks(x, pe, w1, w2):
    B, G, T, dh = x.shape
    nc = T // CMP_STRIDE
    xp = jnp.pad(x, ((0, 0), (0, 0), (0, CMP_BLOCK - CMP_STRIDE), (0, 0)))
    parts = [xp[:, :, j * CMP_STRIDE:j * CMP_STRIDE + T].reshape(B, G, nc, CMP_STRIDE, dh)
             for j in range(CMP_BLOCK // CMP_STRIDE)]
    blocks = jnp.concatenate(parts, axis=3) + pe
    hidden = jax.nn.gelu(blocks.reshape(B, G, nc, CMP_BLOCK * dh) @ w1)
    return hidden @ w2


def nsa_shared_kv(h, kv_w, pe_k, w1_k, w2_k, pe_v, w1_v, w2_v):
    B, T, _ = h.shape
    G, dh = NSA_KV_HEADS, NSA_DH
    kv = (h @ kv_w).reshape(B, T, N_KV_STREAMS, G, dh).transpose(2, 0, 3, 1, 4)
    k_cmp = compress_blocks(kv[0], pe_k, w1_k, w2_k)
    v_cmp = compress_blocks(kv[1], pe_v, w1_v, w2_v)
    n_slc = T // SLC_BLOCK
    k_slc = kv[2].reshape(B, G, n_slc, SLC_BLOCK, dh)
    v_slc = kv[3].reshape(B, G, n_slc, SLC_BLOCK, dh)
    pad = ((0, 0), (0, 0), (WINDOW, 0), (0, 0))
    k_win = jnp.pad(kv[4], pad)
    v_win = jnp.pad(kv[5], pad)
    return k_cmp, v_cmp, k_slc, v_slc, k_win, v_win


def nsa_mixer(h, w_in, w_out, k_cmp, v_cmp, k_slc, v_slc, k_win, v_win):
    B, T, _ = h.shape
    G, J, dh = NSA_KV_HEADS, NSA_GROUP, NSA_DH
    nq = T // Q_BLOCK
    n_cmp = k_cmp.shape[2]
    n_slc = k_slc.shape[2]
    top_k = min(SLC_TOPK, n_slc)
    scale = dh ** -0.5
    slopes = alibi_slopes(NSA_HEADS).reshape(1, G, J, 1, 1)
    proj = h @ w_in
    q = proj[..., :NSA_HEADS * dh].reshape(B, nq, Q_BLOCK, G, J, dh).transpose(1, 0, 3, 4, 2, 5)
    gates = jax.nn.sigmoid(proj[..., NSA_HEADS * dh:].astype(jnp.float32))
    gates = gates.reshape(B, nq, Q_BLOCK, G, J, 3).transpose(1, 0, 3, 4, 2, 5)
    cmp_end = jnp.arange(n_cmp) * CMP_STRIDE + (CMP_BLOCK - 1)
    slc_idx = jnp.arange(n_slc)
    tok_in_blk = jnp.arange(SLC_BLOCK)
    win_off = jnp.arange(WINDOW + Q_BLOCK)
    bi = jnp.arange(B)[:, None, None, None]
    gi = jnp.arange(G)[None, :, None, None]
    r = SLC_BLOCK // CMP_STRIDE
    left = CMP_BLOCK // CMP_STRIDE - 1

    def block(args):
        qi, qb, gb = args
        t_pos = qi * Q_BLOCK + jnp.arange(Q_BLOCK)
        dist_c = t_pos[:, None] - cmp_end[None, :]
        s_c = (jnp.einsum('bgjqd,bgcd->bgjqc', qb, k_cmp).astype(jnp.float32) * scale
               - slopes * dist_c.astype(jnp.float32))
        p_cmp = masked_softmax(s_c, dist_c >= 0)
        o_cmp = jnp.einsum('bgjqc,bgcd->bgjqd', p_cmp.astype(v_cmp.dtype), v_cmp)
        imp = jnp.pad(p_cmp.sum(axis=2), ((0, 0), (0, 0), (0, 0), (left, r)))
        imp_slc = imp[..., 0:r * n_slc:r]
        for u in range(1, r + left):
            imp_slc = imp_slc + imp[..., u:u + r * n_slc:r]
        cur = t_pos // SLC_BLOCK
        blk_ok = slc_idx[None, :] <= cur[:, None]
        forced = ((slc_idx[None, :] == 0) | (slc_idx[None, :] == cur[:, None])
                  | (slc_idx[None, :] == cur[:, None] - 1))
        score = jnp.where(blk_ok, imp_slc + FORCE_BONUS * forced, NEG_INF)
        top_s, top_i = lax.top_k(score, top_k)
        k_sel = k_slc[bi, gi, top_i].reshape(B, G, Q_BLOCK, top_k * SLC_BLOCK, dh)
        v_sel = v_slc[bi, gi, top_i].reshape(B, G, Q_BLOCK, top_k * SLC_BLOCK, dh)
        pos5 = top_i[..., None] * SLC_BLOCK + tok_in_blk
        dist5 = t_pos[None, None, :, None, None] - pos5
        ok5 = (top_s > NEG_INF * 0.5)[..., None] & (dist5 >= 0)
        dist_s = dist5.reshape(B, G, Q_BLOCK, top_k * SLC_BLOCK)[:, :, None]
        ok_s = ok5.reshape(B, G, Q_BLOCK, top_k * SLC_BLOCK)[:, :, None]
        s_s = (jnp.einsum('bgjqd,bgqkd->bgjqk', qb, k_sel).astype(jnp.float32) * scale
               - slopes * dist_s.astype(jnp.float32))
        p_s = masked_softmax(s_s, ok_s)
        o_sel = jnp.einsum('bgjqk,bgqkd->bgjqd', p_s.astype(v_sel.dtype), v_sel)
        kw = lax.dynamic_slice_in_dim(k_win, qi * Q_BLOCK, WINDOW + Q_BLOCK, axis=2)
        vw = lax.dynamic_slice_in_dim(v_win, qi * Q_BLOCK, WINDOW + Q_BLOCK, axis=2)
        pos_w = qi * Q_BLOCK - WINDOW + win_off
        dist_w = t_pos[:, None] - pos_w[None, :]
        ok_w = (pos_w[None, :] >= 0) & (dist_w >= 0) & (dist_w < WINDOW)
        s_w = (jnp.einsum('bgjqd,bgkd->bgjqk', qb, kw).astype(jnp.float32) * scale
               - slopes * dist_w.astype(jnp.float32))
        p_w = masked_softmax(s_w, ok_w)
        o_win = jnp.einsum('bgjqk,bgkd->bgjqd', p_w.astype(vw.dtype), vw)
        out = (gb[..., 0:1] * o_cmp.astype(jnp.float32) + gb[..., 1:2] * o_sel.astype(jnp.float32)
               + gb[..., 2:3] * o_win.astype(jnp.float32))
        return out.astype(h.dtype)

    outs = lax.map(block, (jnp.arange(nq), q, gates))
    o = outs.transpose(1, 0, 4, 2, 3, 5).reshape(B, T, NSA_HEADS * dh)
    return o @ w_out


def setup_inputs(seed: int = 0) -> dict:
    key = jax.random.key(seed)
    ks = jax.random.split(key, 24)
    f32 = jnp.float32

    def nrm(k, shape, fan_in):
        return jax.random.normal(k, shape, f32) * fan_in ** -0.5

    def gain(k, shape):
        return 1.0 + 0.01 * jax.random.normal(k, shape, f32)

    hk = HG_HEADS * HG_DK
    hv = HG_HEADS * HG_DV
    a_in_width = 2 * hk + 2 * hv
    b_q_width = NSA_HEADS * NSA_DH
    b_in_width = b_q_width + 3 * NSA_HEADS
    kv_width = N_KV_STREAMS * NSA_KV_HEADS * NSA_DH
    cmp_in = CMP_BLOCK * NSA_DH
    return {
        'x': jax.random.normal(ks[0], (BATCH, SEQ, D_MODEL), f32),
        'a_norm_w': gain(ks[1], (N_A_LAYERS, D_MODEL)),
        'a_w_in': nrm(ks[2], (N_A_LAYERS, D_MODEL, a_in_width), D_MODEL),
        'a_gnorm_w': gain(ks[3], (N_A_LAYERS, HG_DV)),
        'a_w_out': nrm(ks[4], (N_A_LAYERS, hv, D_MODEL), hv),
        'a_lower_bounds': 0.5 * jax.random.normal(ks[5], (N_A_LAYERS, hk), f32),
        'kv_norm_w': gain(ks[6], (D_MODEL,)),
        'kv_w': nrm(ks[7], (D_MODEL, kv_width), D_MODEL),
        'cmp_pe_k': 0.1 * jax.random.normal(ks[8], (CMP_BLOCK, NSA_DH), f32),
        'cmp_w1_k': nrm(ks[9], (cmp_in, CMP_HIDDEN), cmp_in),
        'cmp_w2_k': nrm(ks[10], (CMP_HIDDEN, NSA_DH), CMP_HIDDEN),
        'cmp_pe_v': 0.1 * jax.random.normal(ks[11], (CMP_BLOCK, NSA_DH), f32),
        'cmp_w1_v': nrm(ks[12], (cmp_in, CMP_HIDDEN), cmp_in),
        'cmp_w2_v': nrm(ks[13], (CMP_HIDDEN, NSA_DH), CMP_HIDDEN),
        'b_norm_w': gain(ks[14], (N_B_LAYERS, D_MODEL)),
        'b_w_in': nrm(ks[15], (N_B_LAYERS, D_MODEL, b_in_width), D_MODEL),
        'b_w_out': nrm(ks[16], (N_B_LAYERS, b_q_width, D_MODEL), b_q_width),
        'mlp_norm_w': gain(ks[17], (DEPTH, D_MODEL)),
        'mlp_w_up': nrm(ks[18], (DEPTH, D_MODEL, D_FF), D_MODEL),
        'mlp_w_down': nrm(ks[19], (DEPTH, D_FF, D_MODEL), D_FF),
        'final_norm_w': gain(ks[20], (D_MODEL,)),
    }


def reference(x, a_norm_w, a_w_in, a_gnorm_w, a_w_out, a_lower_bounds, kv_norm_w, kv_w,
              cmp_pe_k, cmp_w1_k, cmp_w2_k, cmp_pe_v, cmp_w1_v, cmp_w2_v,
              b_norm_w, b_w_in, b_w_out, mlp_norm_w, mlp_w_up, mlp_w_down, final_norm_w):
    lbs = hgrn2_lower_bounds(a_lower_bounds)
    shared = None
    for layer in range(DEPTH):
        if layer < N_A_LAYERS:
            x = x + hgrn2_mixer(rmsnorm(x, a_norm_w[layer]), a_w_in[layer], a_gnorm_w[layer],
                                a_w_out[layer], lbs[layer])
        else:
            if shared is None:
                shared = nsa_shared_kv(rmsnorm(x, kv_norm_w), kv_w, cmp_pe_k, cmp_w1_k, cmp_w2_k,
                                       cmp_pe_v, cmp_w1_v, cmp_w2_v)
            b = layer - N_A_LAYERS
            x = x + nsa_mixer(rmsnorm(x, b_norm_w[b]), b_w_in[b], b_w_out[b], *shared)
        x = x + squared_relu_mlp(rmsnorm(x, mlp_norm_w[layer]), mlp_w_up[layer], mlp_w_down[layer])
    return rmsnorm(x, final_norm_w)
```

```cpp
#include <hip/hip_runtime.h>
#include <cstdio>
#include <cstdint>

typedef unsigned short bf16;
#define DEV __device__ __forceinline__

constexpr int T = 16384, D = 1024, FF = 4096;
constexpr int HG_H = 8, HG_DK = 128, HG_DV = 128;
constexpr int NH = 16, NG = 4, NJ = 4, DH = 64;
constexpr int NCMP = 1024, NSLC = 256, TOPK = 16, WIN = 512;
constexpr int KVW = 1536;
constexpr int BIN = 1072, BINP = 1280;
constexpr float EPS = 1e-6f;

constexpr size_t MiB = 1u << 20;
constexpr size_t WS_CTL = 0;
constexpr size_t WS_XB = 1 * MiB;
constexpr size_t WS_SSQ = 33 * MiB;
constexpr size_t WS_MISC = 34 * MiB;
constexpr size_t WS_WIN = 36 * MiB, WS_WOUT = 44 * MiB, WS_WUP = 46 * MiB, WS_WDN = 54 * MiB, WS_WKV = 62 * MiB;
constexpr size_t WS_BIG = 67 * MiB;
constexpr size_t WS_PROJ = WS_BIG;
constexpr size_t WS_KV = WS_BIG + 128 * MiB;
constexpr size_t WS_CMP = WS_BIG + 178 * MiB;
constexpr size_t WS_GATES = WS_BIG + 180 * MiB;
constexpr size_t WS_END = WS_BIG + 184 * MiB;

DEV float bf2f(bf16 b) { return __uint_as_float(((unsigned)b) << 16); }
DEV bf16 f2bf(float f) { unsigned u = __float_as_uint(f); u += 0x7fffu + ((u >> 16) & 1u); return (bf16)(u >> 16); }
DEV float wave_sum(float v) {
#pragma unroll
    for (int o = 1; o < 64; o <<= 1) v += __shfl_xor(v, o);
    return v;
}
DEV float wave_max(float v) {
#pragma unroll
    for (int o = 1; o < 64; o <<= 1) v = fmaxf(v, __shfl_xor(v, o));
    return v;
}
DEV float rinv_of(const float* ssq, int m) { const float4* p = (const float4*)(ssq + 16 * (size_t)m); const float4 a = p[0], b = p[1], c = p[2], d = p[3];
    const float s = (((a.x + a.y) + (a.z + a.w)) + ((b.x + b.y) + (b.z + b.w))) + (((c.x + c.y) + (c.z + c.w)) + ((d.x + d.y) + (d.z + d.w)));
    return rsqrtf(s * (1.0f / D) + EPS); }

__global__ __launch_bounds__(256) void k_prep_x(const float* __restrict__ xin, float* xout, bf16* xb, float* ssq) {
    const int lane = threadIdx.x & 63, wid = threadIdx.x >> 6;
    for (int m = blockIdx.x * 4 + wid; m < T; m += gridDim.x * 4) {
        const float4* xr = (const float4*)(xin + (size_t)m * D) + lane;
        float ps[4];
#pragma unroll
        for (int j = 0; j < 4; ++j) {
            const float4 v = xr[64 * j];
            if (xout) ((float4*)(xout + (size_t)m * D))[lane + 64 * j] = v;
            ushort4 o; o.x = f2bf(v.x); o.y = f2bf(v.y); o.z = f2bf(v.z); o.w = f2bf(v.w);
            ((ushort4*)(xb + (size_t)m * D))[lane + 64 * j] = o;
            ps[j] = wave_sum((v.x * v.x + v.y * v.y) + (v.z * v.z + v.w * v.w));
        }
        if (lane < 4) *(float4*)(ssq + 16 * (size_t)m + 4 * lane) = make_float4(lane == 0 ? ps[0] : lane == 1 ? ps[1] : lane == 2 ? ps[2] : ps[3], 0.f, 0.f, 0.f);
    }
}

__global__ __launch_bounds__(256) void k_convert_w(const float* __restrict__ W, const float* __restrict__ sc, bf16* Wt, int K, int N, int Npad) {
    __shared__ float tile[64][65];
    const int nb = Npad / 64, kb = K / 64;
    for (int it = blockIdx.x; it < nb * kb; it += gridDim.x) {
        const int k0 = (it / nb) * 64, n0 = (it % nb) * 64;
        for (int e = threadIdx.x; e < 4096; e += 256) { const int kk = e >> 6, nn = e & 63; const int n = n0 + nn;
            tile[kk][nn] = n < N ? W[(size_t)(k0 + kk) * N + n] * (sc ? sc[k0 + kk] : 1.0f) : 0.f; }
        __syncthreads();
        for (int e = threadIdx.x; e < 4096; e += 256) { const int nn = e >> 6, kk = e & 63; Wt[(size_t)(n0 + nn) * K + k0 + kk] = f2bf(tile[kk][nn]); }
        __syncthreads();
    }
}

struct EpiStoreBf16 {
    bf16* O; const float* ssq; int ldo; int act;
    DEV void operator()(int m, int n, float v) const { if (ssq) v *= rinv_of(ssq, m); if (act == 1) { v = fmaxf(v, 0.f); v = v * v; } O[(size_t)m * ldo + n] = f2bf(v); }
};
struct EpiResid {
    float* x;
    DEV void operator()(int m, int n, float v) const { x[(size_t)m * D + n] += v; }
};
struct EpiProjB {
    bf16* Q; float* gates; const float* ssq;
    DEV void operator()(int m, int n, float v) const { v *= rinv_of(ssq, m); if (n < 1024) Q[(size_t)m * D + n] = f2bf(v); else if (n < BIN) gates[(size_t)m * 48 + (n - 1024)] = 1.0f / (1.0f + __expf(-v)); }
};
template <class Epi>
__global__ __launch_bounds__(256) void k_gemm_naive(const bf16* __restrict__ A, int lda, const bf16* __restrict__ Bt, int M, int N, int K, Epi epi) {
    __shared__ float As[32][68], Bs[32][68];
    const int tid = threadIdx.x, tx = tid & 15, ty = tid >> 4;
    const int nbn = N / 64, nbm = M / 64;
    for (int tile = blockIdx.x; tile < nbn * nbm; tile += gridDim.x) {
        const int m0 = (tile / nbn) * 64, n0 = (tile % nbn) * 64;
        float acc[4][4] = {};
        for (int k0 = 0; k0 < K; k0 += 32) {
            { const int r = tid >> 2, ks = (tid & 3) * 8;
              const uint4 av = *(const uint4*)(A + (size_t)(m0 + r) * lda + k0 + ks);
              const uint4 bv = *(const uint4*)(Bt + (size_t)(n0 + r) * K + k0 + ks);
              const unsigned aw[4] = {av.x, av.y, av.z, av.w}, bw[4] = {bv.x, bv.y, bv.z, bv.w};
#pragma unroll
              for (int j = 0; j < 4; ++j) { As[ks + 2 * j][r] = __uint_as_float(aw[j] << 16); As[ks + 2 * j + 1][r] = __uint_as_float(aw[j] & 0xffff0000u);
                                            Bs[ks + 2 * j][r] = __uint_as_float(bw[j] << 16); Bs[ks + 2 * j + 1][r] = __uint_as_float(bw[j] & 0xffff0000u); } }
            __syncthreads();
#pragma unroll 8
            for (int kk = 0; kk < 32; ++kk) {
                const float4 a = *(const float4*)&As[kk][ty * 4], b = *(const float4*)&Bs[kk][tx * 4];
                const float av[4] = {a.x, a.y, a.z, a.w}, bv[4] = {b.x, b.y, b.z, b.w};
#pragma unroll
                for (int i = 0; i < 4; ++i)
#pragma unroll
                    for (int j = 0; j < 4; ++j) acc[i][j] = fmaf(av[i], bv[j], acc[i][j]);
            }
            __syncthreads();
        }
#pragma unroll
        for (int i = 0; i < 4; ++i)
#pragma unroll
            for (int j = 0; j < 4; ++j) epi(m0 + ty * 4 + i, n0 + tx * 4 + j, acc[i][j]);
    }
}

__global__ __launch_bounds__(128) void k_hgrn_naive(bf16* proj, const float* __restrict__ lbp  , int layer, const float* __restrict__ gw  ) {
    constexpr int TB = 16;
    __shared__ float qs[TB][128], fs[TB][128], ks[TB][128], red[TB][2];
    const int h = blockIdx.x, i = threadIdx.x, lane = i & 63, wid = i >> 6;
    float lb = 0.f;
    if (layer == 1) { const float a0 = lbp[h * 128 + i], a1 = lbp[1024 + h * 128 + i]; lb = 1.0f / (1.0f + __expf(a0 - a1)); }
    const float gwi = gw[i];
    float S[128];
#pragma unroll
    for (int d = 0; d < 128; ++d) S[d] = 0.f;
    for (int t0 = 0; t0 < T; t0 += TB) {
        float vv[TB], gg[TB];
#pragma unroll
        for (int tt = 0; tt < TB; ++tt) {
            const bf16* row = proj + (size_t)(t0 + tt) * 4096 + h * 128 + i;
            const float q = bf2f(row[0]), x = bf2f(row[1024]);
            vv[tt] = bf2f(row[2048]); gg[tt] = bf2f(row[3072]);
            const float sg = 1.0f / (1.0f + __expf(-x));
            const float f = fmaxf(lb + (1.0f - lb) * sg, 1e-30f);
            const float k = (1.0f - lb) * (1.0f / (1.0f + __expf(x)));
            qs[tt][i] = q; fs[tt][i] = f; ks[tt][i] = k;
        }
        __syncthreads();
        float o[TB];
#pragma unroll
        for (int tt = 0; tt < TB; ++tt) {
            float acc = 0.f; const float v = vv[tt];
#pragma unroll
            for (int d = 0; d < 128; ++d) { S[d] = fmaf(fs[tt][d], S[d], ks[tt][d] * v); acc = fmaf(qs[tt][d], S[d], acc); }
            o[tt] = acc;
            const float p = wave_sum(acc * acc);
            if (lane == 0) red[tt][wid] = p;
        }
        __syncthreads();
#pragma unroll
        for (int tt = 0; tt < TB; ++tt) {
            const float ms = (red[tt][0] + red[tt][1]) * (1.0f / 128.0f);
            const float g = gg[tt];
            const float val = o[tt] * rsqrtf(ms + EPS) * gwi * (g / (1.0f + __expf(-g)));
            proj[(size_t)(t0 + tt) * 4096 + h * 128 + i] = f2bf(val);
        }
        __syncthreads();
    }
}

DEV float gelu_tanh(float x) { const float u = 0.7978845608028654f * (x + 0.044715f * x * x * x); return 0.5f * x * (1.0f + tanhf(u)); }
__global__ __launch_bounds__(256) void k_compress_naive(const bf16* __restrict__ kv, const float* __restrict__ pe_k, const float* __restrict__ w1_k, const float* __restrict__ w2_k,
                                                        const float* __restrict__ pe_v, const float* __restrict__ w1_v, const float* __restrict__ w2_v, bf16* cmp) {
    __shared__ float blk[2048], hid[256];
    for (int it = blockIdx.x; it < 2 * NG * NCMP; it += gridDim.x) {
        const int s = it / (NG * NCMP), g = (it / NCMP) % NG, i = it % NCMP;
        const float* pe = s ? pe_v : pe_k; const float* w1 = s ? w1_v : w1_k; const float* w2 = s ? w2_v : w2_k;
        for (int e = threadIdx.x; e < 2048; e += 256) { const int tok = 16 * i + (e >> 6), d = e & 63;
            blk[e] = (tok < T ? bf2f(kv[(size_t)tok * KVW + s * 256 + g * 64 + d]) : 0.f) + pe[e]; }
        __syncthreads();
        { float a = 0.f; const int n = threadIdx.x;
          for (int k = 0; k < 2048; ++k) a = fmaf(blk[k], w1[(size_t)k * 256 + n], a);
          hid[n] = gelu_tanh(a); }
        __syncthreads();
        if (threadIdx.x < 64) { float a = 0.f; const int d = threadIdx.x;
            for (int n = 0; n < 256; ++n) a = fmaf(hid[n], w2[n * 64 + d], a);
            cmp[((size_t)(s * NG + g) * NCMP + i) * 64 + d] = f2bf(a); }
        __syncthreads();
    }
}

__global__ __launch_bounds__(256) void k_nsa_naive(bf16* qb  , const float* __restrict__ gates, const bf16* __restrict__ kv, const bf16* __restrict__ cmp) {
    __shared__ float P[4][1024], imp[1024], score[256], qs[4][64];
    __shared__ int sel[16];
    const int lane = threadIdx.x & 63, j = threadIdx.x >> 6;
    for (int it = blockIdx.x; it < T * NG; it += gridDim.x) {
        const int t = it / NG, g = it % NG, h = g * 4 + j;
        const float slope = exp2f(-0.5f * (float)(h + 1));
        qs[j][lane] = bf2f(qb[(size_t)t * D + h * 64 + lane]);
        __syncthreads();
        float q[64];
#pragma unroll
        for (int d = 0; d < 64; ++d) q[d] = qs[j][d];
        const int nvalid = t >= 31 ? (t - 31) / 16 + 1 : 0;
        const bf16* kc = cmp + (size_t)g * NCMP * 64; const bf16* vc = kc + (size_t)NG * NCMP * 64;
        float mx = -3e38f;
        for (int c = lane; c < nvalid; c += 64) {
            const uint4* kr = (const uint4*)(kc + (size_t)c * 64); float a = 0.f;
#pragma unroll
            for (int u = 0; u < 8; ++u) { const uint4 w = kr[u]; const unsigned ww[4] = {w.x, w.y, w.z, w.w};
#pragma unroll
                for (int e = 0; e < 4; ++e) { a = fmaf(q[u * 8 + 2 * e], __uint_as_float(ww[e] << 16), a); a = fmaf(q[u * 8 + 2 * e + 1], __uint_as_float(ww[e] & 0xffff0000u), a); } }
            const float sc = a * 0.125f - slope * (float)(t - 16 * c - 31);
            P[j][c] = sc; mx = fmaxf(mx, sc);
        }
        mx = wave_max(mx);
        float sm = 0.f;
        for (int c = lane; c < nvalid; c += 64) { const float e = __expf(P[j][c] - mx); P[j][c] = e; sm += e; }
        sm = wave_sum(sm);
        const float isum = nvalid > 0 ? 1.0f / sm : 0.f;
        for (int c = lane; c < 1024; c += 64) P[j][c] = c < nvalid ? P[j][c] * isum : 0.f;
        __builtin_amdgcn_s_waitcnt(0); __builtin_amdgcn_wave_barrier();
        float ocmp = 0.f;
        for (int c = 0; c < nvalid; ++c) ocmp = fmaf(P[j][c], bf2f(vc[(size_t)c * 64 + lane]), ocmp);
        __syncthreads();
        for (int c = threadIdx.x; c < 1024; c += 256) imp[c] = (P[0][c] + P[1][c]) + (P[2][c] + P[3][c]);
        __syncthreads();
        const int cur = t >> 6;
        { const int ns = threadIdx.x; float a = 0.f;
#pragma unroll
          for (int u = 0; u < 5; ++u) { const int c = 4 * ns + u - 1; if (c >= 0 && c < 1024) a += imp[c]; }
          const bool forced = (ns == 0) || (ns == cur) || (ns == cur - 1);
          score[ns] = ns <= cur ? a + (forced ? 1e4f : 0.f) : -1e30f; }
        __syncthreads();
        if (j == 0) {
            float sv[4];
#pragma unroll
            for (int u = 0; u < 4; ++u) sv[u] = score[lane + 64 * u];
            for (int r = 0; r < TOPK; ++r) {
                float bs = sv[0]; int bi = lane;
#pragma unroll
                for (int u = 1; u < 4; ++u) if (sv[u] > bs) { bs = sv[u]; bi = lane + 64 * u; }
#pragma unroll
                for (int o = 1; o < 64; o <<= 1) { const float os = __shfl_xor(bs, o); const int oi = __shfl_xor(bi, o); if (os > bs || (os == bs && oi < bi)) { bs = os; bi = oi; } }
                if (lane == 0) sel[r] = bs > -0.5e30f ? bi : -1;
#pragma unroll
                for (int u = 0; u < 4; ++u) if (bi == lane + 64 * u) sv[u] = -3e38f;
            }
        }
        __syncthreads();
        float osel = 0.f;
        {
            float m2 = -3e38f;
            for (int r = 0; r < TOPK; ++r) { const int b = sel[r]; float sc = -3e38f;
                if (b >= 0) { const int pos = 64 * b + lane;
                    if (pos <= t) { const uint4* kr = (const uint4*)(kv + (size_t)pos * KVW + 2 * 256 + g * 64); float a = 0.f;
#pragma unroll
                        for (int u = 0; u < 8; ++u) { const uint4 w = kr[u]; const unsigned ww[4] = {w.x, w.y, w.z, w.w};
#pragma unroll
                            for (int e = 0; e < 4; ++e) { a = fmaf(q[u * 8 + 2 * e], __uint_as_float(ww[e] << 16), a); a = fmaf(q[u * 8 + 2 * e + 1], __uint_as_float(ww[e] & 0xffff0000u), a); } }
                        sc = a * 0.125f - slope * (float)(t - pos); } }
                P[j][r * 64 + lane] = sc; m2 = fmaxf(m2, sc); }
            m2 = wave_max(m2);
            float s2 = 0.f;
            for (int r = 0; r < TOPK; ++r) { const float sc = P[j][r * 64 + lane]; const float e = sc > -1e38f ? __expf(sc - m2) : 0.f; P[j][r * 64 + lane] = e; s2 += e; }
            s2 = wave_sum(s2);
            __builtin_amdgcn_s_waitcnt(0); __builtin_amdgcn_wave_barrier();
            for (int r = 0; r < TOPK; ++r) { const int b = sel[r]; if (b < 0) continue;
                for (int kk = 0; kk < 64; ++kk) { const int pos = 64 * b + kk; if (pos > t) break;
                    osel = fmaf(P[j][r * 64 + kk], bf2f(kv[(size_t)pos * KVW + 3 * 256 + g * 64 + lane]), osel); } }
            osel /= s2;
            __builtin_amdgcn_s_waitcnt(0); __builtin_amdgcn_wave_barrier();
        }
        float owin = 0.f;
        {
            const int p0 = t - (WIN - 1);
            float m3 = -3e38f;
            for (int r = 0; r < 8; ++r) { const int pos = p0 + r * 64 + lane; float sc = -3e38f;
                if (pos >= 0) { const uint4* kr = (const uint4*)(kv + (size_t)pos * KVW + 4 * 256 + g * 64); float a = 0.f;
#pragma unroll
                    for (int u = 0; u < 8; ++u) { const uint4 w = kr[u]; const unsigned ww[4] = {w.x, w.y, w.z, w.w};
#pragma unroll
                        for (int e = 0; e < 4; ++e) { a = fmaf(q[u * 8 + 2 * e], __uint_as_float(ww[e] << 16), a); a = fmaf(q[u * 8 + 2 * e + 1], __uint_as_float(ww[e] & 0xffff0000u), a); } }
                    sc = a * 0.125f - slope * (float)(t - pos); }
                P[j][r * 64 + lane] = sc; m3 = fmaxf(m3, sc); }
            m3 = wave_max(m3);
            float s3 = 0.f;
            for (int r = 0; r < 8; ++r) { const float sc = P[j][r * 64 + lane]; const float e = sc > -1e38f ? __expf(sc - m3) : 0.f; P[j][r * 64 + lane] = e; s3 += e; }
            s3 = wave_sum(s3);
            __builtin_amdgcn_s_waitcnt(0); __builtin_amdgcn_wave_barrier();
            for (int kk = 0; kk < WIN; ++kk) { const int pos = p0 + kk; if (pos < 0) continue;
                owin = fmaf(P[j][kk], bf2f(kv[(size_t)pos * KVW + 5 * 256 + g * 64 + lane]), owin); }
            owin /= s3;
        }
        const float* gt = gates + (size_t)t * 48 + h * 3;
        const float out = gt[0] * ocmp + gt[1] * osel + gt[2] * owin;
        qb[(size_t)t * D + h * 64 + lane] = f2bf(out);
        __syncthreads();
    }
}

__global__ __launch_bounds__(256) void k_final_norm(float* x, const float* __restrict__ w) {
    const int lane = threadIdx.x & 63, wid = threadIdx.x >> 6;
    for (int m = blockIdx.x * 4 + wid; m < T; m += gridDim.x * 4) {
        float4* xr = (float4*)(x + (size_t)m * D) + lane; float4 v[4]; float s = 0.f;
#pragma unroll
        for (int j = 0; j < 4; ++j) { v[j] = xr[64 * j]; s += (v[j].x * v[j].x + v[j].y * v[j].y) + (v[j].z * v[j].z + v[j].w * v[j].w); }
        const float r = rsqrtf(wave_sum(s) * (1.0f / D) + EPS);
#pragma unroll
        for (int j = 0; j < 4; ++j) { const float4 ww = ((const float4*)w)[lane + 64 * j]; xr[64 * j] = make_float4(v[j].x * r * ww.x, v[j].y * r * ww.y, v[j].z * r * ww.z, v[j].w * r * ww.w); }
    }
}
__global__ void k_zero(unsigned* p, size_t n) { for (size_t i = (size_t)blockIdx.x * blockDim.x + threadIdx.x; i < n; i += (size_t)gridDim.x * blockDim.x) p[i] = 0u; }


#define LAS __attribute__((address_space(3)))
typedef short bf16x8 __attribute__((ext_vector_type(8)));
typedef float f32x4 __attribute__((ext_vector_type(4)));
typedef unsigned u32x4 __attribute__((ext_vector_type(4)));
constexpr int NWAVES = 8, NTHR = 512;
constexpr int LDS_BYTES = 147456;
DEV unsigned cvt_pk_bf16(float lo, float hi) { unsigned r; asm volatile("v_cvt_pk_bf16_f32 %0, %1, %2" : "=v"(r) : "v"(lo), "v"(hi)); return r; }
DEV float rinv16(const float* ssq, int m) { const float4* p = (const float4*)(ssq + 16 * (size_t)m); const float4 a = p[0], b = p[1], c = p[2], d = p[3];
    const float s = (((a.x + a.y) + (a.z + a.w)) + ((b.x + b.y) + (b.z + b.w))) + (((c.x + c.y) + (c.z + c.w)) + ((d.x + d.y) + (d.z + d.w)));
    return rsqrtf(s * (1.0f / D) + EPS); }

namespace pg8 {
constexpr int BM = 256, BK = 64, HALF = 128, HTB = HALF * BK * 2, STAGE_BYTES = 8 * HTB, NXCD = 8, WGM = 8;
__host__ __device__ __forceinline__ int lds_byte(int r, int c) { const int st = (r >> 4) * 2 + (c >> 5), rr = r & 15, cc = c & 31, ob = rr * 64 + cc * 2; return st * 1024 + (ob ^ (((ob >> 9) & 1) << 5)); }
__host__ __device__ __forceinline__ void stage_rc(int b, int& R, int& C) { const int st = b / 1024, sb = b % 1024, swz = sb ^ (((sb >> 9) & 1) << 5); R = (st >> 1) * 16 + swz / 64; C = (st & 1) * 32 + (swz % 64) / 2; }
__host__ __device__ __forceinline__ int perm32(int rho) { const int n = rho >> 4, i = rho & 15; return 8 * (i >> 2) + 4 * n + (i & 3); }
struct Unit { int pm, pn; };
struct Sched {
    const bf16* A; const bf16* Bt; int lda, K; int nM, nN, nwg, G, c;
    __device__ void init(const bf16* A_, int lda_, const bf16* Bt_, int M, int N, int K_, int G_, int c_) { A = A_; Bt = Bt_; lda = lda_; K = K_; nM = M / BM; nN = N / BM; nwg = nM * nN; G = G_; c = c_; }
    __device__ bool next(int i, Unit& u) const {
        const long L = (long)i * G + c; if (L >= nwg) return false;
        int wgid = (int)L; { const int q = nwg / NXCD, r = nwg % NXCD, xcd = wgid % NXCD, off = wgid / NXCD; wgid = (xcd < r ? xcd * (q + 1) : r * (q + 1) + (xcd - r) * q) + off; }
        const int nig = WGM * nN, gid = wgid / nig, fm = gid * WGM, gsz = (nM - fm) < WGM ? (nM - fm) : WGM;
        u.pm = fm + ((wgid % nig) % gsz); u.pn = (wgid % nig) / gsz; return true;
    }
    __device__ __forceinline__ int nk() const { return K / BK; }
    __device__ __forceinline__ unsigned a_pitch() const { return (unsigned)lda * 2u; }
    __device__ __forceinline__ unsigned a_kstep() const { return BK * 2u; }
    __device__ __forceinline__ const char* a_ptr(const Unit& u) const { return (const char*)A + (size_t)u.pm * BM * lda * 2; }
    __device__ __forceinline__ const char* b_ptr(const Unit& u) const { return (const char*)Bt + (size_t)u.pn * BM * K * 2; }
};

template <class Epi, class S_t, bool ALIGN_EPI = true>
__device__ __forceinline__ void gemm_phase(LAS unsigned char* lds, const S_t& S, const Epi& E) {
    const int tid = threadIdx.x, wid = __builtin_amdgcn_readfirstlane(tid >> 6), lane = tid & 63, wr = wid >> 2, wc = wid & 3, fr = lane & 15, fq = lane >> 4;
    const int K = S.K, nt = S.nk();
    const unsigned apitch = S.a_pitch();
    unsigned voffA[2], voffB[2];
#pragma unroll
    for (int i = 0; i < 2; ++i) { int R, C; stage_rc(tid * 16 + i * 8192, R, C); const int Rb = (R & ~31) + perm32(R & 31);
        voffA[i] = (unsigned)R * apitch + (unsigned)C * 2u; voffB[i] = (unsigned)(Rb * K + C) * 2u; }
    const size_t kstepA = S.a_kstep(), kstepB = (size_t)(BK * 2);
    const size_t hstepA = (size_t)HALF * apitch, hstepB = (size_t)HALF * K * 2;
    const unsigned ldsw = (unsigned)wid * 1024u;
    const int aoff = lds_byte(wr * 64 + fr, fq * 8), boff = lds_byte(wc * 32 + fr, fq * 8);
#define PG8_SA(b, h) (((b) * 2 + (h)) * HTB)
#define PG8_SB(b, h) ((4 + (b) * 2 + (h)) * HTB)
#define PG8_STAGE(bufoff, gbase, voff) do { _Pragma("unroll") for (int _i = 0; _i < 2; ++_i) \
        __builtin_amdgcn_global_load_lds((const unsigned*)((const char*)(gbase) + (voff)[_i]), (LAS unsigned*)(lds + (bufoff) + ldsw + _i * 8192), 16, 0, 0); } while (0)
#define PG8_LDA(dst, b, h) do { _Pragma("unroll") for (int m = 0; m < 4; ++m) _Pragma("unroll") for (int k = 0; k < 2; ++k) dst[m][k] = *(const LAS bf16x8*)(lds + PG8_SA(b, h) + aoff + m * 2048 + k * 1024); } while (0)
#define PG8_LDB(dst, b, h) do { _Pragma("unroll") for (int n = 0; n < 2; ++n) _Pragma("unroll") for (int k = 0; k < 2; ++k) dst[n][k] = *(const LAS bf16x8*)(lds + PG8_SB(b, h) + boff + n * 2048 + k * 1024); } while (0)
#define PG8_MMA(ai, bj, At, Bt) do { __builtin_amdgcn_s_setprio(1); _Pragma("unroll") for (int m = 0; m < 4; ++m) _Pragma("unroll") for (int n = 0; n < 2; ++n) _Pragma("unroll") for (int k = 0; k < 2; ++k) \
        acc[ai][bj][m][n] = __builtin_amdgcn_mfma_f32_16x16x32_bf16(Bt[n][k], At[m][k], acc[ai][bj][m][n], 0, 0, 0); __builtin_amdgcn_s_setprio(0); } while (0)
#define PG8_WAIT_V(n) asm volatile("s_waitcnt vmcnt(" #n ")" ::: "memory")
#define PG8_WAIT_L(n) asm volatile("s_waitcnt lgkmcnt(" #n ")" ::: "memory")
#define PG8_BAR __builtin_amdgcn_s_barrier()
#define PG8_SCHED __builtin_amdgcn_sched_barrier(0)
    Unit cur, nxt; int ui = 0;
    if (!S.next(0, cur)) return;
    f32x4 acc[2][2][4][2];
#pragma unroll
    for (int a = 0; a < 2; ++a)
#pragma unroll
        for (int b = 0; b < 2; ++b)
#pragma unroll
            for (int m = 0; m < 4; ++m)
#pragma unroll
                for (int n = 0; n < 2; ++n) acc[a][b][m][n] = (f32x4){0.f, 0.f, 0.f, 0.f};
    bf16x8 At[4][2], B0[2][2], B1[2][2];
    const char* cA = S.a_ptr(cur); const char* cB = S.b_ptr(cur);
    PG8_STAGE(PG8_SB(0, 0), cB, voffB); PG8_STAGE(PG8_SB(0, 1), cB + hstepB, voffB); PG8_STAGE(PG8_SA(0, 0), cA, voffA); PG8_STAGE(PG8_SA(0, 1), cA + hstepA, voffA);
    if (wr == 1) PG8_BAR;
    PG8_WAIT_V(2); PG8_BAR;
    PG8_STAGE(PG8_SB(1, 0), cB + kstepB, voffB); PG8_STAGE(PG8_SA(1, 0), cA + kstepA, voffA); PG8_STAGE(PG8_SB(1, 1), cB + hstepB + kstepB, voffB);
    PG8_WAIT_V(6); PG8_BAR;
    for (;;) {
        const bool has_next = S.next(ui + 1, nxt);
        const char* nA = has_next ? S.a_ptr(nxt) : cA; const char* nB = has_next ? S.b_ptr(nxt) : cB;
        for (int t = 0; t < nt; t += 2) {
            const bool last = (t == nt - 2);
            const char* a1 = cA + (size_t)(t + 1) * kstepA;
            const char* a2 = last ? nA : cA + (size_t)(t + 2) * kstepA; const char* b2 = last ? nB : cB + (size_t)(t + 2) * kstepB;
            const char* a3 = a2 + kstepA; const char* b3 = b2 + kstepB;
            PG8_LDB(B0, 0, 0); PG8_LDB(B1, 0, 1); PG8_SCHED; PG8_LDA(At, 0, 0); PG8_STAGE(PG8_SA(1, 1), a1 + hstepA, voffA);
            PG8_WAIT_V(8); PG8_WAIT_L(0); PG8_BAR; PG8_MMA(0, 0, At, B0); PG8_MMA(0, 1, At, B1); PG8_BAR; PG8_SCHED;
            PG8_LDA(At, 0, 1); PG8_STAGE(PG8_SB(0, 0), b2, voffB); PG8_STAGE(PG8_SB(0, 1), b2 + hstepB, voffB); PG8_STAGE(PG8_SA(0, 0), a2, voffA);
            PG8_WAIT_V(8); PG8_WAIT_L(0); PG8_BAR; PG8_MMA(1, 0, At, B0); PG8_MMA(1, 1, At, B1); PG8_BAR; PG8_SCHED;
            PG8_LDB(B0, 1, 0); PG8_LDB(B1, 1, 1); PG8_SCHED; PG8_LDA(At, 1, 0); PG8_STAGE(PG8_SA(0, 1), a2 + hstepA, voffA);
            PG8_WAIT_V(8); PG8_WAIT_L(0); PG8_BAR; PG8_MMA(0, 0, At, B0); PG8_MMA(0, 1, At, B1); PG8_BAR; PG8_SCHED;
            PG8_LDA(At, 1, 1); PG8_STAGE(PG8_SB(1, 0), b3, voffB); PG8_STAGE(PG8_SB(1, 1), b3 + hstepB, voffB); PG8_STAGE(PG8_SA(1, 0), a3, voffA);
            PG8_WAIT_V(8); PG8_WAIT_L(0); PG8_BAR; PG8_MMA(1, 0, At, B0); PG8_MMA(1, 1, At, B1); PG8_BAR; PG8_SCHED;
        }
        if constexpr (ALIGN_EPI) { if (wr == 0) PG8_BAR; }
        E(acc, cur, wr, wc, fr, fq);
        if (!has_next) break;
#pragma unroll
        for (int a = 0; a < 2; ++a)
#pragma unroll
            for (int b = 0; b < 2; ++b)
#pragma unroll
                for (int m = 0; m < 4; ++m)
#pragma unroll
                    for (int n = 0; n < 2; ++n) acc[a][b][m][n] = (f32x4){0.f, 0.f, 0.f, 0.f};
        cur = nxt; cA = nA; cB = nB; ++ui;
        if constexpr (ALIGN_EPI) { if (wr == 1) PG8_BAR; }
    }
    PG8_WAIT_V(0);
    if constexpr (!ALIGN_EPI) { if (wr == 0) PG8_BAR; }
    PG8_BAR;
#undef PG8_SA
#undef PG8_SB
#undef PG8_STAGE
#undef PG8_LDA
#undef PG8_LDB
#undef PG8_MMA
#undef PG8_WAIT_V
#undef PG8_WAIT_L
#undef PG8_BAR
#undef PG8_SCHED
}
}

struct EpiRowBf16 {
    bf16* O; const float* ssq; int ldc; int act;
    DEV void operator()(const f32x4 (&acc)[2][2][4][2], const pg8::Unit& u, int wr, int wc, int fr, int fq) const {
        const int row0 = u.pm * 256 + wr * 64 + fr, col0 = u.pn * 256 + wc * 32 + 8 * fq;
#pragma unroll
        for (int ai = 0; ai < 2; ++ai)
#pragma unroll
            for (int m = 0; m < 4; ++m) { const int r = row0 + ai * 128 + m * 16; const float ri = ssq ? rinv16(ssq, r) : 1.0f; bf16* rowp = O + (size_t)r * ldc + col0;
#pragma unroll
                for (int bj = 0; bj < 2; ++bj) { f32x4 v0 = acc[ai][bj][m][0] * ri, v1 = acc[ai][bj][m][1] * ri;
                    if (act == 1) {
#pragma unroll
                        for (int e = 0; e < 4; ++e) { const float a = fmaxf(v0[e], 0.f), b = fmaxf(v1[e], 0.f); v0[e] = a * a; v1[e] = b * b; } }
                    u32x4 w; w.x = cvt_pk_bf16(v0[0], v0[1]); w.y = cvt_pk_bf16(v0[2], v0[3]); w.z = cvt_pk_bf16(v1[0], v1[1]); w.w = cvt_pk_bf16(v1[2], v1[3]);
                    *(u32x4*)(rowp + bj * 128) = w; } }
    }
};
struct EpiResidual {
    float* x; bf16* xb; float* ssq;
    DEV void operator()(const f32x4 (&acc)[2][2][4][2], const pg8::Unit& u, int wr, int wc, int fr, int fq) const {
        const int row0 = u.pm * 256 + wr * 64 + fr, col0 = u.pn * 256 + wc * 32 + 8 * fq;
#pragma unroll
        for (int ai = 0; ai < 2; ++ai)
#pragma unroll
            for (int m = 0; m < 4; ++m) { const int r = row0 + ai * 128 + m * 16; float part = 0.f;
#pragma unroll
                for (int bj = 0; bj < 2; ++bj) { float* p = x + (size_t)r * D + col0 + bj * 128;
                    f32x4 v0 = *(const f32x4*)p + acc[ai][bj][m][0], v1 = *(const f32x4*)(p + 4) + acc[ai][bj][m][1];
                    *(f32x4*)p = v0; *(f32x4*)(p + 4) = v1;
                    u32x4 w; w.x = cvt_pk_bf16(v0[0], v0[1]); w.y = cvt_pk_bf16(v0[2], v0[3]); w.z = cvt_pk_bf16(v1[0], v1[1]); w.w = cvt_pk_bf16(v1[2], v1[3]);
                    *(u32x4*)(xb + (size_t)r * D + col0 + bj * 128) = w;
                    part += ((v0[0] * v0[0] + v0[1] * v0[1]) + (v0[2] * v0[2] + v0[3] * v0[3])) + ((v1[0] * v1[0] + v1[1] * v1[1]) + (v1[2] * v1[2] + v1[3] * v1[3])); }
                part += __shfl_xor(part, 16); part += __shfl_xor(part, 32);
                if (fq == 0) ssq[(size_t)r * 16 + u.pn * 4 + wc] = part; }
    }
};
struct EpiQG {
    bf16* Q; float* gates; const float* ssq;
    DEV void operator()(const f32x4 (&acc)[2][2][4][2], const pg8::Unit& u, int wr, int wc, int fr, int fq) const {
        const int row0 = u.pm * 256 + wr * 64 + fr, cl = wc * 32 + 8 * fq;
        if (u.pn < 4) {
#pragma unroll
            for (int ai = 0; ai < 2; ++ai)
#pragma unroll
                for (int m = 0; m < 4; ++m) { const int r = row0 + ai * 128 + m * 16; const float ri = rinv16(ssq, r);
#pragma unroll
                    for (int bj = 0; bj < 2; ++bj) { const f32x4 v0 = acc[ai][bj][m][0] * ri, v1 = acc[ai][bj][m][1] * ri;
                        u32x4 w; w.x = cvt_pk_bf16(v0[0], v0[1]); w.y = cvt_pk_bf16(v0[2], v0[3]); w.z = cvt_pk_bf16(v1[0], v1[1]); w.w = cvt_pk_bf16(v1[2], v1[3]);
                        *(u32x4*)(Q + (size_t)r * D + u.pn * 256 + cl + bj * 128) = w; } }
        } else if (cl < 48) {
#pragma unroll
            for (int ai = 0; ai < 2; ++ai)
#pragma unroll
                for (int m = 0; m < 4; ++m) { const int r = row0 + ai * 128 + m * 16; const float ri = rinv16(ssq, r);
                    const f32x4 v0 = acc[ai][0][m][0] * ri, v1 = acc[ai][0][m][1] * ri; f32x4 g0, g1;
#pragma unroll
                    for (int e = 0; e < 4; ++e) { g0[e] = 1.0f / (1.0f + __expf(-v0[e])); g1[e] = 1.0f / (1.0f + __expf(-v1[e])); }
                    float* gp = gates + (size_t)r * 48 + cl; *(f32x4*)gp = g0; *(f32x4*)(gp + 4) = g1; }
        }
    }
};


namespace hg {
typedef short s16x4 __attribute__((ext_vector_type(4)));
typedef float f32x2_t __attribute__((ext_vector_type(2))); typedef __bf16 bf16x2_t __attribute__((ext_vector_type(2)));
constexpr int SEGCH = 8, NSEG = T / (64 * SEGCH);
constexpr int L_QT = 0, L_KT = 16384, L_QP = 32768, L_KP = 49152, L_V = 65536, L_ATT = 81920, L_QSUM = 90112, L_EB = 92160, L_RED = 92672;
DEV unsigned cvtpk(float lo, float hi) { f32x2_t v = {lo, hi}; bf16x2_t b = __builtin_convertvector(v, bf16x2_t); return __builtin_bit_cast(unsigned, b); }
DEV int toff(int row, int col) { return row * 256 + ((((col >> 3) ^ row) & 15) << 4) + (col & 7) * 2; }
DEV int aoff(int t, int s) { return t * 128 + ((((s >> 2) ^ t) & 15) << 3); }
DEV s16x4 trr(LAS unsigned char* p) { return __builtin_bit_cast(s16x4, __builtin_amdgcn_ds_read_tr16_b64_v4i16((LAS s16x4*)p)); }
DEV bf16x8 cat(s16x4 a, s16x4 b) { return __builtin_shufflevector(a, b, 0, 1, 2, 3, 4, 5, 6, 7); }
DEV f32x4 mfma16(bf16x8 a, bf16x8 b, f32x4 c) { return __builtin_amdgcn_mfma_f32_16x16x32_bf16(a, b, c, 0, 0, 0); }

template <bool OUT>
DEV void phase(LAS unsigned char* lds, bf16* proj, float* hst, float* bseg, const float* __restrict__ lbp, int layer, const float* __restrict__ gw, int bid, int nblk) {
    const int tid = threadIdx.x, wid = __builtin_amdgcn_readfirstlane(tid >> 6), lane = tid & 63, r16 = lane & 15, g = lane >> 4, q4 = r16 >> 2, p4 = r16 & 3;
    const int d = tid & 127, qd = tid >> 7;
    const int nitems = OUT ? 8 * NSEG : 8 * (NSEG - 1);
    for (int item = bid; item < nitems; item += nblk) {
        const int h = item & 7, seg = item >> 3;
        float lb = 0.f;
        if (layer == 1) { const float a0 = lbp[h * 128 + d], a1 = lbp[1024 + h * 128 + d]; lb = 1.0f / (1.0f + __expf(a0 - a1)); }
        f32x4 S[8];
#pragma unroll
        for (int i = 0; i < 8; ++i) S[i] = (f32x4){0.f, 0.f, 0.f, 0.f};
        if (OUT) {
            for (int j = 0; j < seg; ++j) {
                const float* Lj = hst + ((size_t)((j * 8 + h) * 8 + wid) * 8) * 256 + lane * 4;
                const float* Bj = bseg + (size_t)(j * 8 + h) * 128 + 4 * g;
#pragma unroll
                for (int i = 0; i < 8; ++i) { const f32x4 l4 = *(const f32x4*)(Lj + i * 256); const f32x4 b4 = *(const f32x4*)(Bj + 16 * i);
#pragma unroll
                    for (int e = 0; e < 4; ++e) S[i][e] = fmaf(S[i][e], __builtin_amdgcn_exp2f(b4[e]), l4[e]); }
            }
        }
        f32x4 gw4 = (f32x4){0.f, 0.f, 0.f, 0.f};
        if (OUT) gw4 = *(const f32x4*)(gw + 16 * wid + 4 * g);
        float segB = 0.f;
        for (int c = 0; c < SEGCH; ++c) {
            const int t0 = (seg * SEGCH + c) * 64;
            {
                const bf16* base = proj + (size_t)(t0 + 16 * qd) * 4096 + h * 128 + d;
                float qv[16], kv[16], bb[16]; float cum = 0.f;
#pragma unroll
                for (int i = 0; i < 16; ++i) {
                    const float q = bf2f(base[(size_t)i * 4096]); float x = bf2f(base[(size_t)i * 4096 + 1024]);
                    x = fminf(fmaxf(x, -30.f), 30.f);
                    const float e = __builtin_amdgcn_exp2f(-1.4426950408889634f * x);
                    const float sg = __builtin_amdgcn_rcpf(1.0f + e), oms = e * sg;
                    const float f = fmaxf(lb + (1.0f - lb) * sg, 1e-30f);
                    cum += __builtin_amdgcn_logf(f);
                    qv[i] = q; kv[i] = (1.0f - lb) * oms; bb[i] = cum;
                }
                LAS float* qsum = (LAS float*)(lds + L_QSUM);
                qsum[qd * 128 + d] = cum;
#pragma unroll
                for (int j = 0; j < 2; ++j) { const int cc = tid + 512 * j, row = cc >> 4, ch = cc & 15;
                    const u32x4 vv = *(const u32x4*)(proj + (size_t)(t0 + row) * 4096 + 2048 + h * 128 + ch * 8);
                    *(LAS u32x4*)(lds + L_V + row * 256 + (((ch ^ row) & 15) << 4)) = vv; }
                __syncthreads();
                const float s0 = qsum[d], s1 = qsum[128 + d], s2 = qsum[256 + d], s3 = qsum[384 + d];
                const float off = qd == 0 ? 0.f : (qd == 1 ? s0 : (qd == 2 ? s0 + s1 : (s0 + s1) + s2));
                const float tot = (s0 + s1) + (s2 + s3), ref = s0 + s1;
                if (qd == 0) { *(LAS float*)(lds + L_EB + d * 4) = __builtin_amdgcn_exp2f(tot); segB += tot; }
#pragma unroll
                for (int i = 0; i < 16; ++i) {
                    const float bt = off + bb[i]; const int o = toff(16 * qd + i, d);
                    const float e3 = __builtin_amdgcn_exp2f(bt), e4 = __builtin_amdgcn_exp2f(tot - bt);
                    *(LAS bf16*)(lds + L_KP + o) = (bf16)cvtpk(kv[i] * e4, 0.f);
                    if (OUT) {
                        const float e1 = __builtin_amdgcn_exp2f(fminf(bt - ref, 100.f)), e2 = __builtin_amdgcn_exp2f(fminf(ref - bt, 100.f));
                        *(LAS bf16*)(lds + L_QT + o) = (bf16)cvtpk(qv[i] * e1, 0.f);
                        *(LAS bf16*)(lds + L_KT + o) = (bf16)cvtpk(kv[i] * e2, 0.f);
                        *(LAS bf16*)(lds + L_QP + o) = (bf16)cvtpk(qv[i] * e3, 0.f);
                    }
                }
            }
            __syncthreads();
            f32x4 O[4];
            if (OUT) {
#pragma unroll
                for (int i = 0; i < 2; ++i) {
                    const int idx = 2 * wid + i, st = idx >> 2, tt = idx & 3; unsigned w0 = 0u, w1 = 0u;
                    if (st <= tt) {
                        f32x4 a = (f32x4){0.f, 0.f, 0.f, 0.f};
#pragma unroll
                        for (int ks = 0; ks < 4; ++ks) {
                            const bf16x8 A = *(const LAS bf16x8*)(lds + L_KT + toff(16 * st + r16, 32 * ks + 8 * g));
                            const bf16x8 B = *(const LAS bf16x8*)(lds + L_QT + toff(16 * tt + r16, 32 * ks + 8 * g));
                            a = mfma16(A, B, a);
                        }
                        if (st == tt) {
#pragma unroll
                            for (int e = 0; e < 4; ++e) a[e] = (4 * g + e > r16) ? 0.f : a[e];
                        }
                        w0 = cvtpk(a[0], a[1]); w1 = cvtpk(a[2], a[3]);
                    }
                    const int t = 16 * tt + r16;
                    { typedef unsigned u32x2 __attribute__((ext_vector_type(2))); *(LAS u32x2*)(lds + L_ATT + aoff(t, 16 * st + 4 * g)) = (u32x2){w0, w1}; }
                }
                __syncthreads();
#pragma unroll
                for (int i = 0; i < 4; ++i) O[i] = (f32x4){0.f, 0.f, 0.f, 0.f};
#pragma unroll
                for (int ks = 0; ks < 4; ++ks) {
                    u32x4 sw; sw.x = cvtpk(S[2 * ks][0], S[2 * ks][1]); sw.y = cvtpk(S[2 * ks][2], S[2 * ks][3]); sw.z = cvtpk(S[2 * ks + 1][0], S[2 * ks + 1][1]); sw.w = cvtpk(S[2 * ks + 1][2], S[2 * ks + 1][3]);
                    const bf16x8 A = __builtin_bit_cast(bf16x8, sw);
#pragma unroll
                    for (int tt = 0; tt < 4; ++tt) { const int t = 16 * tt + r16;
                        const s16x4 b0 = *(const LAS s16x4*)(lds + L_QP + toff(t, 32 * ks + 4 * g)), b1 = *(const LAS s16x4*)(lds + L_QP + toff(t, 32 * ks + 16 + 4 * g));
                        O[tt] = mfma16(A, cat(b0, b1), O[tt]); }
                }
#pragma unroll
                for (int ks = 0; ks < 2; ++ks) {
                    const int rowA = 32 * ks + 4 * g + q4, colA = 16 * wid + 4 * p4;
                    const bf16x8 A = cat(trr(lds + L_V + toff(rowA, colA)), trr(lds + L_V + toff(rowA + 16, colA)));
#pragma unroll
                    for (int tt = 0; tt < 4; ++tt) if (32 * ks <= 16 * tt + 15) { const int t = 16 * tt + r16;
                        const s16x4 b0 = *(const LAS s16x4*)(lds + L_ATT + aoff(t, 32 * ks + 4 * g)), b1 = *(const LAS s16x4*)(lds + L_ATT + aoff(t, 32 * ks + 16 + 4 * g));
                        O[tt] = mfma16(A, cat(b0, b1), O[tt]); }
                }
            }
#pragma unroll
            for (int i = 0; i < 8; ++i) { const f32x4 e = *(const LAS f32x4*)(lds + L_EB + (16 * i + 4 * g) * 4); S[i] = S[i] * e; }
#pragma unroll
            for (int ks = 0; ks < 2; ++ks) {
                const int rowB = 32 * ks + 8 * g + q4, colB = 16 * wid + 4 * p4;
                const bf16x8 B = cat(trr(lds + L_V + toff(rowB, colB)), trr(lds + L_V + toff(rowB + 4, colB)));
#pragma unroll
                for (int i = 0; i < 8; ++i) { const int colA = 16 * i + 4 * p4;
                    const bf16x8 A = cat(trr(lds + L_KP + toff(rowB, colA)), trr(lds + L_KP + toff(rowB + 4, colA)));
                    S[i] = mfma16(A, B, S[i]); }
            }
            if (OUT) {
                LAS float* red = (LAS float*)(lds + L_RED);
#pragma unroll
                for (int tt = 0; tt < 4; ++tt) { float p = (O[tt][0] * O[tt][0] + O[tt][1] * O[tt][1]) + (O[tt][2] * O[tt][2] + O[tt][3] * O[tt][3]);
                    p += __shfl_xor(p, 16); p += __shfl_xor(p, 32);
                    if (g == 0) red[wid * 64 + 16 * tt + r16] = p; }
                __syncthreads();
#pragma unroll
                for (int tt = 0; tt < 4; ++tt) { const int t = 16 * tt + r16; float ssum = 0.f;
#pragma unroll
                    for (int w = 0; w < 8; ++w) ssum += red[w * 64 + t];
                    const float ri = rsqrtf(ssum * (1.0f / 128.0f) + EPS);
                    bf16* rowp = proj + (size_t)(t0 + t) * 4096 + h * 128 + 16 * wid + 4 * g;
                    const uint2 gv = *(const uint2*)(rowp + 3072);
                    const float g0 = __uint_as_float(gv.x << 16), g1 = __uint_as_float(gv.x & 0xffff0000u), g2 = __uint_as_float(gv.y << 16), g3 = __uint_as_float(gv.y & 0xffff0000u);
                    const float o0 = O[tt][0] * ri * gw4[0] * (g0 / (1.0f + __expf(-g0))), o1 = O[tt][1] * ri * gw4[1] * (g1 / (1.0f + __expf(-g1)));
                    const float o2 = O[tt][2] * ri * gw4[2] * (g2 / (1.0f + __expf(-g2))), o3 = O[tt][3] * ri * gw4[3] * (g3 / (1.0f + __expf(-g3)));
                    *(uint2*)rowp = make_uint2(cvtpk(o0, o1), cvtpk(o2, o3)); }
            } else {
                __syncthreads();
            }
        }
        if (!OUT) {
            float* Ls = hst + ((size_t)((seg * 8 + h) * 8 + wid) * 8) * 256 + lane * 4;
#pragma unroll
            for (int i = 0; i < 8; ++i) *(f32x4*)(Ls + i * 256) = S[i];
            if (qd == 0) bseg[(size_t)(seg * 8 + h) * 128 + d] = segB;
        }
    }
}
}


namespace nsa {
typedef float f32x16 __attribute__((ext_vector_type(16)));
typedef short s16x4 __attribute__((ext_vector_type(4)));
typedef float f32x2_t __attribute__((ext_vector_type(2))); typedef __bf16 bf16x2_t __attribute__((ext_vector_type(2)));
constexpr int IMPS = 260;
constexpr int L_IMP = 0, L_KV = 66560, L_SELB = 99328, L_WUN = 101376, L_BL = 101632, L_NB = 102720;
constexpr float NINF = -__builtin_inff();
DEV unsigned cvtpk(float lo, float hi) { f32x2_t v = {lo, hi}; bf16x2_t b = __builtin_convertvector(v, bf16x2_t); return __builtin_bit_cast(unsigned, b); }
DEV f32x16 mfma32(bf16x8 a, bf16x8 b, f32x16 c) { return __builtin_amdgcn_mfma_f32_32x32x16_bf16(a, b, c, 0, 0, 0); }
DEV s16x4 trr(LAS unsigned char* p) { return __builtin_bit_cast(s16x4, __builtin_amdgcn_ds_read_tr16_b64_v4i16((LAS s16x4*)p)); }
DEV bf16x8 cat(s16x4 a, s16x4 b) { return __builtin_shufflevector(a, b, 0, 1, 2, 3, 4, 5, 6, 7); }
DEV float ex2(float x) { return __builtin_amdgcn_exp2f(x); }

template <bool WV> DEV void stage(LAS unsigned char* slot, const bf16* kbase, long vdelta, int stride, int wid, int lane) {
    const int row = 8 * wid + (lane >> 3), ch = (lane ^ (lane >> 3)) & 7;
    const unsigned lo = (unsigned)(row * stride + ch * 8) * 2u;
    const char* kp = (const char*)kbase + lo;
    __builtin_amdgcn_global_load_lds((const unsigned*)kp, (LAS unsigned*)(slot + wid * 1024), 16, 0, 0);
    if (WV) __builtin_amdgcn_global_load_lds((const unsigned*)(kp + vdelta), (LAS unsigned*)(slot + 8192 + wid * 1024), 16, 0, 0);
}

struct St { float m, l; f32x16 O0, O1; };

template <int MODE>
DEV void block(LAS unsigned char* slot, const bf16x8 (&qf)[4], const f32x16& kb, float c32, float A, bool need_mask, int lo, int hi_, St& st,
               LAS float* imp, int tokrow, int nsbase, int lane) {
    const int key0 = lane & 31, hi = lane >> 5;
    f32x16 s0 = kb, s1 = kb;
#pragma unroll
    for (int ks = 0; ks < 4; ++ks) {
        const int off = key0 * 128 + ((((2 * ks + hi) ^ key0) & 7) << 4);
        const bf16x8 a0 = *(const LAS bf16x8*)(slot + off), a1 = *(const LAS bf16x8*)(slot + 4096 + off);
        s0 = mfma32(a0, qf[ks], s0); s1 = mfma32(a1, qf[ks], s1);
        __builtin_amdgcn_sched_barrier(0);
    }
    if (need_mask) {
        const int lo2 = lo - 4 * hi, hi2 = hi_ - 4 * hi;
#pragma unroll
        for (int r = 0; r < 16; ++r) { const int c0 = (r & 3) + 8 * (r >> 2), c1 = c0 + 32;
            s0[r] = (c0 >= lo2 && c0 <= hi2) ? s0[r] : NINF; s1[r] = (c1 >= lo2 && c1 <= hi2) ? s1[r] : NINF; }
    }
    if (MODE == 0) {
        float m0 = s0[0], m1 = s1[0];
#pragma unroll
        for (int r = 1; r < 16; ++r) { m0 = fmaxf(m0, s0[r]); m1 = fmaxf(m1, s1[r]); }
        float mloc = fmaxf(m0, m1 + c32);
        mloc = fmaxf(mloc, __shfl_xor(mloc, 32));
        const float mnew = fmaxf(st.m, mloc + A), alpha = ex2(st.m - mnew), sh0 = A - mnew, sh1 = sh0 + c32;
        float ls = 0.f;
#pragma unroll
        for (int r = 0; r < 16; ++r) { s0[r] = ex2(s0[r] + sh0); s1[r] = ex2(s1[r] + sh1); ls += s0[r] + s1[r]; }
        st.l = st.l * alpha + ls; st.m = mnew;
        if (!__all(alpha == 1.0f)) { st.O0 = st.O0 * alpha; st.O1 = st.O1 * alpha; }
        bf16x8 pb[2][2];
#pragma unroll
        for (int s = 0; s < 2; ++s) {
            u32x4 w0, w1;
            w0.x = cvtpk(s0[8 * s + 0], s0[8 * s + 1]); w0.y = cvtpk(s0[8 * s + 2], s0[8 * s + 3]); w0.z = cvtpk(s0[8 * s + 4], s0[8 * s + 5]); w0.w = cvtpk(s0[8 * s + 6], s0[8 * s + 7]);
            w1.x = cvtpk(s1[8 * s + 0], s1[8 * s + 1]); w1.y = cvtpk(s1[8 * s + 2], s1[8 * s + 3]); w1.z = cvtpk(s1[8 * s + 4], s1[8 * s + 5]); w1.w = cvtpk(s1[8 * s + 6], s1[8 * s + 7]);
            pb[0][s] = __builtin_bit_cast(bf16x8, w0); pb[1][s] = __builtin_bit_cast(bf16x8, w1);
        }
        const int i16 = lane & 15, q4 = i16 >> 2, p4 = i16 & 3, dsub = (lane >> 4) & 1;
#pragma unroll
        for (int tau = 0; tau < 2; ++tau)
#pragma unroll
            for (int s = 0; s < 2; ++s) {
                const int row = 32 * tau + 16 * s + 4 * hi + q4;
#pragma unroll
                for (int dt = 0; dt < 2; ++dt) {
                    const int col = 32 * dt + 16 * dsub + 4 * p4;
                    const int o0 = 8192 + row * 128 + ((((col >> 3) ^ row) & 7) << 4) + ((col >> 2) & 1) * 8;
                    const int o1 = 8192 + (row + 8) * 128 + ((((col >> 3) ^ (row + 8)) & 7) << 4) + ((col >> 2) & 1) * 8;
                    const bf16x8 va = cat(trr(slot + o0), trr(slot + o1));
                    if (dt == 0) st.O0 = mfma32(va, pb[tau][s], st.O0); else st.O1 = mfma32(va, pb[tau][s], st.O1);
                }
                __builtin_amdgcn_sched_barrier(0);
            }
    } else {
        const float sh0 = st.m + A, sh1 = sh0 + c32;
#pragma unroll
        for (int tau = 0; tau < 2; ++tau)
#pragma unroll
            for (int a = 0; a < 4; ++a) {
                float p0, p1, p2, p3;
                if (tau == 0) { p0 = ex2(s0[4 * a] + sh0); p1 = ex2(s0[4 * a + 1] + sh0); p2 = ex2(s0[4 * a + 2] + sh0); p3 = ex2(s0[4 * a + 3] + sh0); }
                else { p0 = ex2(s1[4 * a] + sh1); p1 = ex2(s1[4 * a + 1] + sh1); p2 = ex2(s1[4 * a + 2] + sh1); p3 = ex2(s1[4 * a + 3] + sh1); }
                float Q = (p0 + p1) + (p2 + p3), L = p3;
                Q += __shfl_xor(Q, 1); L += __shfl_xor(L, 1); Q += __shfl_xor(Q, 2); L += __shfl_xor(L, 2);
                if ((lane & 3) == 0) { LAS float* ip = imp + tokrow * IMPS + nsbase + 8 * tau + 2 * a + hi;
                    __hip_atomic_fetch_add(ip, Q, __ATOMIC_RELAXED, __HIP_MEMORY_SCOPE_WORKGROUP);
                    __hip_atomic_fetch_add(ip + 1, L, __ATOMIC_RELAXED, __HIP_MEMORY_SCOPE_WORKGROUP); }
            }
    }
}

DEV void phase(LAS unsigned char* lds, bf16* qb, const float* __restrict__ gates, const bf16* __restrict__ kv, const bf16* __restrict__ cmp, int bid, int nblk) {
    const int tid0 = threadIdx.x, wid = __builtin_amdgcn_readfirstlane(tid0 >> 6);
    LAS float* imp = (LAS float*)(lds + L_IMP);
    LAS unsigned* selb = (LAS unsigned*)(lds + L_SELB);
    LAS unsigned* wun = (LAS unsigned*)(lds + L_WUN);
    LAS int* blist = (LAS int*)(lds + L_BL);
    LAS int* nbp = (LAS int*)(lds + L_NB);
    for (int item = bid; item < 1024; item += nblk) {
        int tid = tid0; asm volatile("" : "+v"(tid));
        const int lane = tid & 63, n = lane & 31, hi = lane >> 5;
        const int g = item >> 8, cq = item & 255, qt = (g & 1) ? 255 - cq : cq, cur = qt;
        const int tok = 8 * wid + (n >> 2), t = 64 * qt + tok, tl = tok, head = 4 * g + (n & 3);
        const float sl2 = ex2(-0.5f * (float)(head + 1)) * 1.4426950408889634f;
        for (int i = tid; i < 64 * IMPS; i += NTHR) imp[i] = 0.f;
        bf16x8 qf[4];
        {
            const bf16* qp = qb + (size_t)t * D + head * 64 + 8 * hi;
#pragma unroll
            for (int ks = 0; ks < 4; ++ks) { const u32x4 w = *(const u32x4*)(qp + 16 * ks); const float sc = 0.125f * 1.4426950408889634f; u32x4 o;
                o.x = cvtpk(__uint_as_float(w.x << 16) * sc, __uint_as_float(w.x & 0xffff0000u) * sc); o.y = cvtpk(__uint_as_float(w.y << 16) * sc, __uint_as_float(w.y & 0xffff0000u) * sc);
                o.z = cvtpk(__uint_as_float(w.z << 16) * sc, __uint_as_float(w.z & 0xffff0000u) * sc); o.w = cvtpk(__uint_as_float(w.w << 16) * sc, __uint_as_float(w.w & 0xffff0000u) * sc);
                qf[ks] = __builtin_bit_cast(bf16x8, o); }
        }
        const float* gp = gates + (size_t)t * 48 + head * 3;
        const float gt0 = gp[0], gt1 = gp[1], gt2 = gp[2];
        f32x16 out0, out1;
#pragma unroll
        for (int r = 0; r < 16; ++r) { out0[r] = 0.f; out1[r] = 0.f; }
        f32x16 kb;
        St st;
        __syncthreads();
        const int tlast = 64 * qt + 63;
        const int nct = tlast >= 31 ? (((tlast - 31) >> 4) >> 6) + 1 : 0;
        const bf16* kc = cmp + (size_t)g * NCMP * 64; const long vcd = (long)NG * NCMP * 64 * 2;
        const int cmax = (t - 31) >> 4;
#pragma unroll
        for (int r = 0; r < 16; ++r) kb[r] = fmaf(sl2 * 16.f, (float)((r & 3) + 8 * (r >> 2)), sl2 * 64.f * (float)hi);
        float c32 = sl2 * 512.f;
        st.m = -1e30f; st.l = 0.f;
#pragma unroll
        for (int r = 0; r < 16; ++r) { st.O0[r] = 0.f; st.O1[r] = 0.f; }
        if (nct > 0) {
            stage<true>(lds + L_KV, kc, vcd, 64, wid, lane);
            for (int kt = 0; kt < nct; ++kt) {
                LAS unsigned char* slot = lds + L_KV + (kt & 1) * 16384;
                __syncthreads();
                if (kt + 1 < nct) stage<true>(lds + L_KV + ((kt + 1) & 1) * 16384, kc + (size_t)(kt + 1) * 4096, vcd, 64, wid, lane);
                const float A = -sl2 * (float)(t - 1024 * kt - 31);
                block<0>(slot, qf, kb, c32, A, true, 0, cmax - 64 * kt, st, imp, tok, 16 * kt, lane);
            }
        }
        float ltot = st.l + __shfl_xor(st.l, 32);
        {
            const float inv = ltot > 0.f ? 1.0f / ltot : 0.f, sc = gt0 * inv;
            out0 = st.O0 * sc; out1 = st.O1 * sc;
        }
        if (nct > 0) {
            St sb; sb.m = ltot > 0.f ? -st.m - __builtin_amdgcn_logf(ltot) : NINF; sb.l = 0.f;
            __syncthreads();
            stage<false>(lds + L_KV, kc, vcd, 64, wid, lane);
            for (int kt = 0; kt < nct; ++kt) {
                LAS unsigned char* slot = lds + L_KV + (kt & 1) * 16384;
                __syncthreads();
                if (kt + 1 < nct) stage<false>(lds + L_KV + ((kt + 1) & 1) * 16384, kc + (size_t)(kt + 1) * 4096, vcd, 64, wid, lane);
                const float A = -sl2 * (float)(t - 1024 * kt - 31);
                block<1>(slot, qf, kb, c32, A, true, 0, cmax - 64 * kt, sb, imp, tok, 16 * kt, lane);
            }
        }
        __builtin_amdgcn_s_waitcnt(0xc07f); __builtin_amdgcn_wave_barrier();
        {
            const int tk = lane >> 3, u = lane & 7;
            const LAS float* ir = imp + (8 * wid + tk) * IMPS + u;
            unsigned sc[32];
#pragma unroll
            for (int i = 0; i < 32; ++i) { const int ns = u + 8 * i; float v = ir[8 * i];
                const bool forced = (ns == 0) || (ns == cur) || (ns == cur - 1);
                if (forced) v += 1e4f;
                sc[i] = ns <= cur ? ((__float_as_uint(v) & 0xFFFFFE00u) | (unsigned)(256 - ns)) : 0u; }
            unsigned mybits = 0u;
            const int nsel = cur + 1 < TOPK ? cur + 1 : TOPK;
            for (int r = 0; r < nsel; ++r) {
                unsigned mx = sc[0];
#pragma unroll
                for (int i = 1; i < 32; ++i) mx = mx > sc[i] ? mx : sc[i];
                { unsigned o = __shfl_xor(mx, 1); mx = mx > o ? mx : o; o = __shfl_xor(mx, 2); mx = mx > o ? mx : o; o = __shfl_xor(mx, 4); mx = mx > o ? mx : o; }
#pragma unroll
                for (int i = 0; i < 32; ++i) sc[i] = sc[i] == mx ? 0u : sc[i];
                const int wns = 256 - (int)(mx & 0x1FFu);
                if ((wns & 7) == u) mybits |= 1u << (wns >> 3);
            }
            selb[(8 * wid + tk) * 8 + u] = mybits;
            unsigned wu = mybits; wu |= __shfl_xor(wu, 8); wu |= __shfl_xor(wu, 16); wu |= __shfl_xor(wu, 32);
            if (lane < 8) wun[wid * 8 + lane] = wu;
        }
        __syncthreads();
        if (wid == 0) {
            int base = 0;
            for (int k = 0; k < 4; ++k) { const int b = 64 * k + lane; unsigned w = 0u;
#pragma unroll
                for (int ww = 0; ww < 8; ++ww) w |= wun[ww * 8 + (b & 7)];
                const bool bit = (w >> (b >> 3)) & 1u;
                const unsigned long long bal = __ballot(bit);
                const int pos = base + __popcll(bal & ((1ull << lane) - 1ull));
                if (bit) blist[pos] = b;
                base += __popcll(bal); }
            if (lane == 0) *nbp = base;
        }
        __syncthreads();
        const int nb = *nbp;
#pragma unroll
        for (int r = 0; r < 16; ++r) kb[r] = fmaf(sl2, (float)((r & 3) + 8 * (r >> 2)), sl2 * 4.f * (float)hi);
        c32 = sl2 * 32.f;
        st.m = -1e30f; st.l = 0.f;
#pragma unroll
        for (int r = 0; r < 16; ++r) { st.O0[r] = 0.f; st.O1[r] = 0.f; }
        {
            const bf16* ks = kv + 2 * 256 + g * 64;
            int b = blist[0];
            stage<true>(lds + L_KV, ks + (size_t)b * 64 * KVW, 512, KVW, wid, lane);
            for (int i = 0; i < nb; ++i) {
                LAS unsigned char* slot = lds + L_KV + (i & 1) * 16384;
                __syncthreads();
                const int bn = i + 1 < nb ? blist[i + 1] : 0;
                if (i + 1 < nb) stage<true>(lds + L_KV + ((i + 1) & 1) * 16384, ks + (size_t)bn * 64 * KVW, 512, KVW, wid, lane);
                const unsigned wmine = wun[wid * 8 + (b & 7)];
                if ((wmine >> (b >> 3)) & 1u) {
                    const bool member = (selb[tok * 8 + (b & 7)] >> (b >> 3)) & 1u;
                    const float A = member ? -sl2 * (float)(t - 64 * b) : NINF;
                    block<0>(slot, qf, kb, c32, A, b == cur, 0, tl, st, imp, tok, 0, lane);
                }
                b = bn;
            }
        }
        ltot = st.l + __shfl_xor(st.l, 32);
        { const float inv = ltot > 0.f ? 1.0f / ltot : 0.f, sc = gt1 * inv; out0 = out0 + st.O0 * sc; out1 = out1 + st.O1 * sc; }
        st.m = -1e30f; st.l = 0.f;
#pragma unroll
        for (int r = 0; r < 16; ++r) { st.O0[r] = 0.f; st.O1[r] = 0.f; }
        {
            const bf16* kw = kv + 4 * 256 + g * 64;
            const int b0 = cur >= 8 ? cur - 8 : 0, nw = cur - b0 + 1;
            __syncthreads();
            stage<true>(lds + L_KV, kw + (size_t)b0 * 64 * KVW, 512, KVW, wid, lane);
            for (int i = 0; i < nw; ++i) {
                const int b = b0 + i;
                LAS unsigned char* slot = lds + L_KV + (i & 1) * 16384;
                __syncthreads();
                if (i + 1 < nw) stage<true>(lds + L_KV + ((i + 1) & 1) * 16384, kw + (size_t)(b + 1) * 64 * KVW, 512, KVW, wid, lane);
                const float A = -sl2 * (float)(t - 64 * b);
                const bool far = (b == cur - 8);
                block<0>(slot, qf, kb, c32, A, far || b == cur, far ? tl + 1 : 0, far ? 63 : tl, st, imp, tok, 0, lane);
            }
        }
        ltot = st.l + __shfl_xor(st.l, 32);
        { const float inv = ltot > 0.f ? 1.0f / ltot : 0.f, sc = gt2 * inv; out0 = out0 + st.O0 * sc; out1 = out1 + st.O1 * sc; }
        {
            bf16* op = qb + (size_t)t * D + head * 64 + 4 * hi;
            typedef unsigned u32x2 __attribute__((ext_vector_type(2)));
#pragma unroll
            for (int a = 0; a < 4; ++a) {
                *(u32x2*)(op + 8 * a) = (u32x2){cvtpk(out0[4 * a], out0[4 * a + 1]), cvtpk(out0[4 * a + 2], out0[4 * a + 3])};
                *(u32x2*)(op + 32 + 8 * a) = (u32x2){cvtpk(out1[4 * a], out1[4 * a + 1]), cvtpk(out1[4 * a + 2], out1[4 * a + 3])};
            }
        }
        __syncthreads();
    }
}
}

struct MArgs { const float* in[21]; float* x; unsigned char* ws; int ph_lo, ph_hi, layer, pad; };
enum Phase { PH_APROJ = 1, PH_AOUT = 2, PH_UP = 3, PH_DOWN = 4, PH_KV = 5, PH_BPROJ = 6, PH_BOUT = 7, PH_HG1 = 8, PH_HG2 = 9, PH_NSA = 10 };
__global__ void __launch_bounds__(NTHR, 2) mega(MArgs a) {
    extern __shared__ __attribute__((aligned(16))) unsigned char lds_raw[];
    LAS unsigned char* lds = (LAS unsigned char*)lds_raw;
    unsigned char* ws = a.ws; float* x = a.x;
    bf16* XB = (bf16*)(ws + WS_XB); float* SSQ = (float*)(ws + WS_SSQ);
    bf16* WIN_ = (bf16*)(ws + WS_WIN); bf16* WOUT = (bf16*)(ws + WS_WOUT); bf16* WUP = (bf16*)(ws + WS_WUP); bf16* WDN = (bf16*)(ws + WS_WDN); bf16* WKVb = (bf16*)(ws + WS_WKV);
    bf16* PROJ = (bf16*)(ws + WS_PROJ); bf16* KV = (bf16*)(ws + WS_KV); float* GATES = (float*)(ws + WS_GATES);
    const int G = gridDim.x, c = blockIdx.x;
#define IN(k) (a.ph_lo <= (k) && (k) < a.ph_hi)
    if (IN(PH_APROJ)) { pg8::Sched S; S.init(XB, D, WIN_, T, 4096, D, G, c); EpiRowBf16 E{PROJ, SSQ, 4096, 0}; pg8::gemm_phase(lds, S, E); }
    if (IN(PH_AOUT)) { pg8::Sched S; S.init(PROJ, 4096, WOUT, T, D, D, G, c); EpiResidual E{x, XB, SSQ}; pg8::gemm_phase(lds, S, E); }
    if (IN(PH_UP)) { pg8::Sched S; S.init(XB, D, WUP, T, FF, D, G, c); EpiRowBf16 E{PROJ, SSQ, FF, 1}; pg8::gemm_phase(lds, S, E); }
    if (IN(PH_DOWN)) { pg8::Sched S; S.init(PROJ, FF, WDN, T, D, FF, G, c); EpiResidual E{x, XB, SSQ}; pg8::gemm_phase(lds, S, E); }
    if (IN(PH_KV)) { pg8::Sched S; S.init(XB, D, WKVb, T, KVW, D, G, c); EpiRowBf16 E{KV, SSQ, KVW, 0}; pg8::gemm_phase(lds, S, E); }
    if (IN(PH_BPROJ)) { pg8::Sched S; S.init(XB, D, WIN_, T, BINP, D, G, c); EpiQG E{PROJ, GATES, SSQ}; pg8::gemm_phase(lds, S, E); }
    if (IN(PH_BOUT)) { pg8::Sched S; S.init(PROJ, D, WOUT, T, D, D, G, c); EpiResidual E{x, XB, SSQ}; pg8::gemm_phase(lds, S, E); }
    if (IN(PH_HG1)) hg::phase<false>(lds, PROJ, (float*)(ws + WS_KV), (float*)(ws + WS_MISC), a.in[5], a.layer, a.in[3] + a.layer * 128, c, G);
    if (IN(PH_HG2)) hg::phase<true>(lds, PROJ, (float*)(ws + WS_KV), (float*)(ws + WS_MISC), a.in[5], a.layer, a.in[3] + a.layer * 128, c, G);
    if (IN(PH_NSA)) nsa::phase(lds, PROJ, GATES, KV, (const bf16*)(ws + WS_CMP), c, G);
#undef IN
}

extern "C" void kernel_launch(void* const* d_in, const int* in_sizes, int n_in, void* d_out, int out_size, void* d_ws, size_t ws_size, hipStream_t stream) {
    if (n_in != 21 || out_size != T * D || ws_size < WS_END) { fprintf(stderr, "kernel_launch: unexpected shapes n_in %d out %d ws %zu (need %zu)\n", n_in, out_size, ws_size, (size_t)WS_END); return; }
    const float* x_in = (const float*)d_in[0];
    const float* a_norm_w = (const float*)d_in[1]; const float* a_w_in = (const float*)d_in[2]; const float* a_gnorm_w = (const float*)d_in[3];
    const float* a_w_out = (const float*)d_in[4]; const float* a_lb = (const float*)d_in[5];
    const float* kv_norm_w = (const float*)d_in[6]; const float* kv_w = (const float*)d_in[7];
    const float* pe_k = (const float*)d_in[8]; const float* w1_k = (const float*)d_in[9]; const float* w2_k = (const float*)d_in[10];
    const float* pe_v = (const float*)d_in[11]; const float* w1_v = (const float*)d_in[12]; const float* w2_v = (const float*)d_in[13];
    const float* b_norm_w = (const float*)d_in[14]; const float* b_w_in = (const float*)d_in[15]; const float* b_w_out = (const float*)d_in[16];
    const float* mlp_norm_w = (const float*)d_in[17]; const float* mlp_up = (const float*)d_in[18]; const float* mlp_dn = (const float*)d_in[19];
    const float* final_w = (const float*)d_in[20];
    float* x = (float*)d_out; unsigned char* ws = (unsigned char*)d_ws;
    bf16* XB = (bf16*)(ws + WS_XB); float* SSQ = (float*)(ws + WS_SSQ);
    bf16* WIN_ = (bf16*)(ws + WS_WIN); bf16* WOUT = (bf16*)(ws + WS_WOUT); bf16* WUP = (bf16*)(ws + WS_WUP); bf16* WDN = (bf16*)(ws + WS_WDN); bf16* WKVb = (bf16*)(ws + WS_WKV);
    bf16* PROJ = (bf16*)(ws + WS_PROJ); bf16* KV = (bf16*)(ws + WS_KV); bf16* CMP = (bf16*)(ws + WS_CMP); float* GATES = (float*)(ws + WS_GATES);
    const int G = 1024;
    static int grid = 0;
    if (grid == 0) {
        int dev = 0, cus = 0; hipGetDevice(&dev); hipDeviceGetAttribute(&cus, hipDeviceAttributeMultiprocessorCount, dev);
        if (hipFuncSetAttribute((const void*)mega, hipFuncAttributeMaxDynamicSharedMemorySize, LDS_BYTES) != hipSuccess) { fprintf(stderr, "kernel_launch: hipFuncSetAttribute failed\n"); grid = -1; return; }
        grid = cus > 0 ? cus : 256;
    }
    if (grid < 0) return;
    auto run = [&](int ph, int layer) { MArgs a{}; for (int i = 0; i < 21; ++i) a.in[i] = (const float*)d_in[i]; a.x = x; a.ws = ws; a.ph_lo = ph; a.ph_hi = ph + 1; a.layer = layer; hipLaunchKernelGGL(mega, dim3(grid), dim3(NTHR), LDS_BYTES, stream, a); };
    k_prep_x<<<G, 256, 0, stream>>>(x_in, x, XB, SSQ);
    auto mlp = [&](int layer) {
        k_convert_w<<<G, 256, 0, stream>>>(mlp_up + (size_t)layer * D * FF, mlp_norm_w + layer * D, WUP, D, FF, FF);
        k_convert_w<<<G, 256, 0, stream>>>(mlp_dn + (size_t)layer * FF * D, nullptr, WDN, FF, D, D);
        run(PH_UP, layer); run(PH_DOWN, layer);
    };
    for (int l = 0; l < 2; ++l) {
        k_convert_w<<<G, 256, 0, stream>>>(a_w_in + (size_t)l * D * 4096, a_norm_w + l * D, WIN_, D, 4096, 4096);
        k_convert_w<<<G, 256, 0, stream>>>(a_w_out + (size_t)l * D * D, nullptr, WOUT, D, D, D);
        run(PH_APROJ, l);
        run(PH_HG1, l); run(PH_HG2, l);
        run(PH_AOUT, l);
        mlp(l);
    }
    k_convert_w<<<G, 256, 0, stream>>>(kv_w, kv_norm_w, WKVb, D, KVW, KVW);
    k_zero<<<64, 256, 0, stream>>>((unsigned*)(KV + (size_t)T * KVW), 16 * KVW / 2);
    run(PH_KV, 0);
    k_compress_naive<<<2048, 256, 0, stream>>>(KV, pe_k, w1_k, w2_k, pe_v, w1_v, w2_v, CMP);
    for (int b = 0; b < 2; ++b) {
        k_convert_w<<<G, 256, 0, stream>>>(b_w_in + (size_t)b * D * BIN, b_norm_w + b * D, WIN_, D, BIN, BINP);
        k_convert_w<<<G, 256, 0, stream>>>(b_w_out + (size_t)b * D * D, nullptr, WOUT, D, D, D);
        run(PH_BPROJ, b);
        run(PH_NSA, b);
        run(PH_BOUT, b);
        mlp(2 + b);
    }
    k_final_norm<<<G, 256, 0, stream>>>(x, final_w);
}
```

```cpp
#include <hip/hip_runtime.h>
#include <hip/hip_cooperative_groups.h>
#include <cstdio>
#include <cstdint>

typedef unsigned short bf16;
#define PROBE 0
#ifndef MK_SINGLE
#define MK_SINGLE 1
#endif
#define DEV __device__ __forceinline__

constexpr int T = 16384, D = 1024, FF = 4096;
constexpr int HG_H = 8, HG_DK = 128, HG_DV = 128;
constexpr int NH = 16, NG = 4, NJ = 4, DH = 64;
constexpr int NCMP = 1024, NSLC = 256, TOPK = 16, WIN = 512;
constexpr int KVW = 1536;
constexpr int BIN = 1072, BINP = 1280;
constexpr float EPS = 1e-6f;

constexpr size_t MiB = 1u << 20;
constexpr size_t WS_CTL = 0;
constexpr size_t WS_XB = 1 * MiB;
constexpr size_t WS_SSQ = 33 * MiB;
constexpr size_t WS_MISC = 34 * MiB;
constexpr size_t WS_WIN = 36 * MiB, WS_WOUT = 44 * MiB, WS_WUP = 46 * MiB, WS_WDN = 54 * MiB, WS_WKV = 62 * MiB;
constexpr size_t WS_BIG = 67 * MiB;
constexpr size_t WS_PROJ = WS_BIG;
constexpr size_t WS_KV = WS_BIG + 128 * MiB;
constexpr size_t WS_CMP = WS_BIG + 178 * MiB;
constexpr size_t WS_GATES = WS_BIG + 180 * MiB;
constexpr size_t WS_END = WS_BIG + 184 * MiB;

DEV float bf2f(bf16 b) { return __uint_as_float(((unsigned)b) << 16); }
DEV bf16 f2bf(float f) { unsigned u = __float_as_uint(f); u += 0x7fffu + ((u >> 16) & 1u); return (bf16)(u >> 16); }
DEV float wave_sum(float v) {
#pragma unroll
    for (int o = 1; o < 64; o <<= 1) v += __shfl_xor(v, o);
    return v;
}
DEV float wave_max(float v) {
#pragma unroll
    for (int o = 1; o < 64; o <<= 1) v = fmaxf(v, __shfl_xor(v, o));
    return v;
}
DEV float rinv_of(const float* ssq, int m) { const float4* p = (const float4*)(ssq + 16 * (size_t)m); const float4 a = p[0], b = p[1], c = p[2], d = p[3];
    const float s = (((a.x + a.y) + (a.z + a.w)) + ((b.x + b.y) + (b.z + b.w))) + (((c.x + c.y) + (c.z + c.w)) + ((d.x + d.y) + (d.z + d.w)));
    return rsqrtf(s * (1.0f / D) + EPS); }

#define LAS __attribute__((address_space(3)))
typedef short bf16x8 __attribute__((ext_vector_type(8)));
typedef float f32x4 __attribute__((ext_vector_type(4)));
typedef unsigned u32x4 __attribute__((ext_vector_type(4)));
constexpr int NWAVES = 8, NTHR = 512;
extern __shared__ __attribute__((aligned(16))) unsigned char dyn_lds_base[];
constexpr int RINV_OFF = 131072 + 4096;
constexpr int LDS_BYTES = 147456;
DEV unsigned cvt_pk_bf16(float lo, float hi) { unsigned r; asm volatile("v_cvt_pk_bf16_f32 %0, %1, %2" : "=v"(r) : "v"(lo), "v"(hi)); return r; }
DEV float xlane32(float x, int lane) { const auto r = __builtin_amdgcn_permlane32_swap(__builtin_bit_cast(unsigned, x), __builtin_bit_cast(unsigned, x), false, false); return __builtin_bit_cast(float, (lane & 32) ? r[0] : r[1]); }
DEV float xlane16(float x, int lane) { const auto r = __builtin_amdgcn_permlane16_swap(__builtin_bit_cast(unsigned, x), __builtin_bit_cast(unsigned, x), false, false); return __builtin_bit_cast(float, (lane & 16) ? r[0] : r[1]); }
DEV float swapadd16(float a, float b) { asm volatile("s_nop 1\n\tv_permlane16_swap_b32 %0, %1" : "+v"(a), "+v"(b)); return a + b; }
DEV float swapadd32(float a, float b) { asm volatile("s_nop 1\n\tv_permlane32_swap_b32 %0, %1" : "+v"(a), "+v"(b)); return a + b; }
DEV float rinv16(const float* ssq, int m) { const float4* p = (const float4*)(ssq + 16 * (size_t)m); const float4 a = p[0], b = p[1], c = p[2], d = p[3];
    const float s = (((a.x + a.y) + (a.z + a.w)) + ((b.x + b.y) + (b.z + b.w))) + (((c.x + c.y) + (c.z + c.w)) + ((d.x + d.y) + (d.z + d.w)));
    return rsqrtf(s * (1.0f / D) + EPS); }

namespace pg8 {
constexpr int BM = 256, BK = 64, HALF = 128, HTB = HALF * BK * 2, STAGE_BYTES = 8 * HTB, NXCD = 8, WGM = 8;
__host__ __device__ __forceinline__ int lds_byte(int r, int c) { const int st = (r >> 4) * 2 + (c >> 5), rr = r & 15, cc = c & 31, ob = rr * 64 + cc * 2; return st * 1024 + (ob ^ (((ob >> 9) & 1) << 5)); }
__host__ __device__ __forceinline__ void stage_rc(int b, int& R, int& C) { const int st = b / 1024, sb = b % 1024, swz = sb ^ (((sb >> 9) & 1) << 5); R = (st >> 1) * 16 + swz / 64; C = (st & 1) * 32 + (swz % 64) / 2; }
__host__ __device__ __forceinline__ int perm32(int rho) { const int n = rho >> 4, i = rho & 15; return 8 * (i >> 2) + 4 * n + (i & 3); }
struct Unit { int pm, pn, ui; };
struct Sched {
    const bf16* A; const bf16* Bt; int lda, K; int nM, nN, nwg, G, c;
    __device__ void init(const bf16* A_, int lda_, const bf16* Bt_, int M, int N, int K_, int G_, int c_) { A = A_; Bt = Bt_; lda = lda_; K = K_; nM = M / BM; nN = N / BM; nwg = nM * nN; G = G_; c = c_; }
    __device__ bool next(int i, Unit& u) const {
        const long L = (long)i * G + c; if (L >= nwg) return false;
        int wgid = (int)L; { const int q = nwg / NXCD, r = nwg % NXCD, xcd = wgid % NXCD, off = wgid / NXCD; wgid = (xcd < r ? xcd * (q + 1) : r * (q + 1) + (xcd - r) * q) + off; }
        const int nig = WGM * nN, gid = wgid / nig, fm = gid * WGM, gsz = (nM - fm) < WGM ? (nM - fm) : WGM;
        u.pm = fm + ((wgid % nig) % gsz); u.pn = (wgid % nig) / gsz; return true;
    }
    __device__ __forceinline__ int nk() const { return K / BK; }
    __device__ __forceinline__ unsigned a_pitch() const { return (unsigned)lda * 2u; }
    __device__ __forceinline__ unsigned a_kstep() const { return BK * 2u; }
    __device__ __forceinline__ const char* a_ptr(const Unit& u) const { return (const char*)A + (size_t)u.pm * BM * lda * 2; }
    __device__ __forceinline__ const char* b_ptr(const Unit& u) const { return (const char*)Bt + (size_t)u.pn * BM * K * 2; }
};

template <class Epi, class S_t, bool ALIGN_EPI = true>
__device__ __forceinline__ void gemm_phase(LAS unsigned char* lds, const S_t& S, const Epi& E, const int tid) {
    const int wid = __builtin_amdgcn_readfirstlane(tid >> 6), lane = tid & 63, wr = wid >> 2, wc = wid & 3, fr = lane & 15, fq = lane >> 4;
    const int K = S.K, nt = S.nk();
    const unsigned apitch = S.a_pitch();
    unsigned voffA[2], voffB[2];
#pragma unroll
    for (int i = 0; i < 2; ++i) { int R, C; stage_rc(tid * 16 + i * 8192, R, C); const int Rb = (R & ~31) + perm32(R & 31);
        voffA[i] = (unsigned)R * apitch + (unsigned)C * 2u; voffB[i] = (unsigned)(Rb * K + C) * 2u; }
    const size_t kstepA = S.a_kstep(), kstepB = (size_t)(BK * 2);
    const size_t hstepA = (size_t)HALF * apitch, hstepB = (size_t)HALF * K * 2;
    const unsigned ldsw = (unsigned)wid * 1024u;
    const int aoff = lds_byte(wr * 64 + fr, fq * 8), boff = lds_byte(wc * 32 + fr, fq * 8);
#define PG8_SA(b, h) (((b) * 2 + (h)) * HTB)
#define PG8_SB(b, h) ((4 + (b) * 2 + (h)) * HTB)
#define PG8_STAGE(bufoff, gbase, voff) do { _Pragma("unroll") for (int _i = 0; _i < 2; ++_i) \
        __builtin_amdgcn_global_load_lds((const unsigned*)((const char*)(gbase) + (voff)[_i]), (LAS unsigned*)(lds + (bufoff) + ldsw + _i * 8192), 16, 0, 0); } while (0)
#define PG8_LDA(dst, b, h) do { _Pragma("unroll") for (int m = 0; m < 4; ++m) _Pragma("unroll") for (int k = 0; k < 2; ++k) dst[m][k] = *(const LAS bf16x8*)(lds + PG8_SA(b, h) + aoff + m * 2048 + k * 1024); } while (0)
#define PG8_LDB(dst, b, h) do { _Pragma("unroll") for (int n = 0; n < 2; ++n) _Pragma("unroll") for (int k = 0; k < 2; ++k) dst[n][k] = *(const LAS bf16x8*)(lds + PG8_SB(b, h) + boff + n * 2048 + k * 1024); } while (0)
#define PG8_MMA(ai, bj, At, Bt) do { __builtin_amdgcn_s_setprio(1); _Pragma("unroll") for (int m = 0; m < 4; ++m) _Pragma("unroll") for (int n = 0; n < 2; ++n) _Pragma("unroll") for (int k = 0; k < 2; ++k) \
        acc[ai][bj][m][n] = __builtin_amdgcn_mfma_f32_16x16x32_bf16(Bt[n][k], At[m][k], acc[ai][bj][m][n], 0, 0, 0); __builtin_amdgcn_s_setprio(0); } while (0)
#define PG8_WAIT_V(n) asm volatile("s_waitcnt vmcnt(" #n ")" ::: "memory")
#define PG8_WAIT_L(n) asm volatile("s_waitcnt lgkmcnt(" #n ")" ::: "memory")
#define PG8_BAR __builtin_amdgcn_s_barrier()
#define PG8_SCHED __builtin_amdgcn_sched_barrier(0)
    Unit cur, nxt; int ui = 0;
    if (!S.next(0, cur)) return;
    cur.ui = 0;
    f32x4 acc[2][2][4][2];
#pragma unroll
    for (int a = 0; a < 2; ++a)
#pragma unroll
        for (int b = 0; b < 2; ++b)
#pragma unroll
            for (int m = 0; m < 4; ++m)
#pragma unroll
                for (int n = 0; n < 2; ++n) acc[a][b][m][n] = (f32x4){0.f, 0.f, 0.f, 0.f};
    bf16x8 At[4][2], B0[2][2], B1[2][2];
    const char* cA = S.a_ptr(cur); const char* cB = S.b_ptr(cur);
    PG8_STAGE(PG8_SB(0, 0), cB, voffB); PG8_STAGE(PG8_SB(0, 1), cB + hstepB, voffB); PG8_STAGE(PG8_SA(0, 0), cA, voffA); PG8_STAGE(PG8_SA(0, 1), cA + hstepA, voffA);
    E.prep(lds, S, tid);
    if (wr == 1) PG8_BAR;
    PG8_WAIT_V(2); PG8_BAR;
    PG8_STAGE(PG8_SB(1, 0), cB + kstepB, voffB); PG8_STAGE(PG8_SA(1, 0), cA + kstepA, voffA); PG8_STAGE(PG8_SB(1, 1), cB + hstepB + kstepB, voffB);
    PG8_WAIT_V(6); PG8_BAR;
    for (;;) {
        const bool has_next = S.next(ui + 1, nxt); nxt.ui = ui + 1;
        const char* nA = has_next ? S.a_ptr(nxt) : cA; const char* nB = has_next ? S.b_ptr(nxt) : cB;
        for (int t = 0; t < nt; t += 2) {
            const bool last = (t == nt - 2);
            const char* a1 = cA + (size_t)(t + 1) * kstepA;
            const char* a2 = last ? nA : cA + (size_t)(t + 2) * kstepA; const char* b2 = last ? nB : cB + (size_t)(t + 2) * kstepB;
            const char* a3 = a2 + kstepA; const char* b3 = b2 + kstepB;
            PG8_LDB(B0, 0, 0); PG8_LDB(B1, 0, 1); PG8_SCHED; PG8_LDA(At, 0, 0); PG8_STAGE(PG8_SA(1, 1), a1 + hstepA, voffA);
            PG8_WAIT_V(8); PG8_WAIT_L(0); PG8_BAR; PG8_MMA(0, 0, At, B0); PG8_MMA(0, 1, At, B1); PG8_BAR; PG8_SCHED;
            PG8_LDA(At, 0, 1); PG8_STAGE(PG8_SB(0, 0), b2, voffB); PG8_STAGE(PG8_SB(0, 1), b2 + hstepB, voffB); PG8_STAGE(PG8_SA(0, 0), a2, voffA);
            PG8_WAIT_V(8); PG8_WAIT_L(0); PG8_BAR; PG8_MMA(1, 0, At, B0); PG8_MMA(1, 1, At, B1); PG8_BAR; PG8_SCHED;
            PG8_LDB(B0, 1, 0); PG8_LDB(B1, 1, 1); PG8_SCHED; PG8_LDA(At, 1, 0); PG8_STAGE(PG8_SA(0, 1), a2 + hstepA, voffA);
            PG8_WAIT_V(8); PG8_WAIT_L(0); PG8_BAR; PG8_MMA(0, 0, At, B0); PG8_MMA(0, 1, At, B1); PG8_BAR; PG8_SCHED;
            PG8_LDA(At, 1, 1); PG8_STAGE(PG8_SB(1, 0), b3, voffB); PG8_STAGE(PG8_SB(1, 1), b3 + hstepB, voffB); PG8_STAGE(PG8_SA(1, 0), a3, voffA);
            PG8_WAIT_V(8); PG8_WAIT_L(0); PG8_BAR; PG8_MMA(1, 0, At, B0); PG8_MMA(1, 1, At, B1); PG8_BAR; PG8_SCHED;
        }
        if constexpr (ALIGN_EPI) { if (wr == 0) PG8_BAR; }
        E(acc, cur, wr, wc, fr, fq);
        if (!has_next) break;
#pragma unroll
        for (int a = 0; a < 2; ++a)
#pragma unroll
            for (int b = 0; b < 2; ++b)
#pragma unroll
                for (int m = 0; m < 4; ++m)
#pragma unroll
                    for (int n = 0; n < 2; ++n) acc[a][b][m][n] = (f32x4){0.f, 0.f, 0.f, 0.f};
        cur = nxt; cA = nA; cB = nB; ++ui;
        if constexpr (ALIGN_EPI) { if (wr == 1) PG8_BAR; }
    }
    PG8_WAIT_V(0);
    if constexpr (!ALIGN_EPI) { if (wr == 0) PG8_BAR; }
    PG8_BAR;
#undef PG8_SA
#undef PG8_SB
#undef PG8_STAGE
#undef PG8_LDA
#undef PG8_LDB
#undef PG8_MMA
#undef PG8_WAIT_V
#undef PG8_WAIT_L
#undef PG8_BAR
#undef PG8_SCHED
}
}

DEV void st16_wt(void* p, u32x4 v) { asm volatile("global_store_dwordx4 %0, %1, off sc1\n\ts_nop 1" :: "v"(p), "v"(v) : "memory"); }
DEV void rinv8(const float* ssq, int row0, int fr, int fq, float (&ri)[8]) {
    const float a = rinv16(ssq, row0 + 128 * (fq >> 1) + 16 * (2 * (fq & 1))), b = rinv16(ssq, row0 + 128 * (fq >> 1) + 16 * (2 * (fq & 1) + 1));
#pragma unroll
    for (int k = 0; k < 8; ++k) ri[k] = __shfl((k & 1) ? b : a, fr + 16 * (k >> 1));
}
struct EpiRowBf16 {
    bf16* O; const float* ssq; int ldc; int act;
    template <class S_t> DEV void prep(LAS unsigned char* lds, const S_t& S, int tid) const {
        LAS float* tab = (LAS float*)(lds + RINV_OFF);
        for (int i = tid; i < 4 * 256; i += NTHR) { pg8::Unit u; if (S.next(i >> 8, u)) tab[i] = rinv16(ssq, u.pm * 256 + (i & 255)); }
        __syncthreads();
    }
    DEV void operator()(const f32x4 (&acc)[2][2][4][2], const pg8::Unit& u, int wr, int wc, int fr, int fq) const {
        const int row0 = u.pm * 256 + wr * 64 + fr, col0 = u.pn * 256 + wc * 32 + 8 * fq;
        float ri8[8];
        if (u.ui < 4) { const LAS float* tab = (const LAS float*)((LAS unsigned char*)dyn_lds_base + RINV_OFF) + u.ui * 256 + wr * 64 + fr;
#pragma unroll
            for (int k = 0; k < 8; ++k) ri8[k] = tab[128 * (k >> 2) + 16 * (k & 3)];
        } else rinv8(ssq, row0, fr, fq, ri8);
#pragma unroll
        for (int ai = 0; ai < 2; ++ai)
#pragma unroll
            for (int m = 0; m < 4; ++m) { const int r = row0 + ai * 128 + m * 16; const float ri = ri8[4 * ai + m]; bf16* rowp = O + (size_t)r * ldc + col0;
#pragma unroll
                for (int bj = 0; bj < 2; ++bj) { f32x4 v0 = acc[ai][bj][m][0] * ri, v1 = acc[ai][bj][m][1] * ri;
                    if (act & 1) {
#pragma unroll
                        for (int e = 0; e < 4; ++e) { const float a = fmaxf(v0[e], 0.f), b = fmaxf(v1[e], 0.f); v0[e] = a * a; v1[e] = b * b; } }
                    u32x4 w; w.x = cvt_pk_bf16(v0[0], v0[1]); w.y = cvt_pk_bf16(v0[2], v0[3]); w.z = cvt_pk_bf16(v1[0], v1[1]); w.w = cvt_pk_bf16(v1[2], v1[3]);
                    if (act & 2) asm volatile("" :: "v"(w)); else st16_wt(rowp + bj * 128, w); } }
    }
};
struct EpiAProj {
    bf16* O; const float* ssq; const float* lbp; int layer;
    template <class S_t> DEV void prep(LAS unsigned char*, const S_t&, int) const {}
    DEV void operator()(const f32x4 (&acc)[2][2][4][2], const pg8::Unit& u, int wr, int wc, int fr, int fq) const {
        const int row0 = u.pm * 256 + wr * 64 + fr, col0 = u.pn * 256 + wc * 32 + 8 * fq;
        if (u.pn >= 4 && u.pn < 8) {
#pragma unroll
            for (int bj = 0; bj < 2; ++bj) {
                float lb[8];
#pragma unroll
                for (int e = 0; e < 8; ++e) { lb[e] = 0.f; if (layer == 1) { const int ch = col0 - 1024 + bj * 128 + e; lb[e] = 1.0f / (1.0f + __expf(lbp[ch] - lbp[1024 + ch])); } }
#pragma unroll
                for (int ai = 0; ai < 2; ++ai)
#pragma unroll
                    for (int m = 0; m < 4; ++m) { const int r = row0 + ai * 128 + m * 16; const float ri = rinv16(ssq, r);
                        float v[8];
#pragma unroll
                        for (int e = 0; e < 4; ++e) { v[e] = acc[ai][bj][m][0][e] * ri; v[4 + e] = acc[ai][bj][m][1][e] * ri; }
#pragma unroll
                        for (int e = 0; e < 8; ++e) { const float xx = fminf(fmaxf(v[e], -30.f), 30.f); const float sg = __builtin_amdgcn_rcpf(1.0f + __builtin_amdgcn_exp2f(-1.4426950408889634f * xx));
                            v[e] = __builtin_amdgcn_logf(fmaxf(lb[e] + (1.0f - lb[e]) * sg, 1e-30f)); }
                        u32x4 w; w.x = cvt_pk_bf16(v[0], v[1]); w.y = cvt_pk_bf16(v[2], v[3]); w.z = cvt_pk_bf16(v[4], v[5]); w.w = cvt_pk_bf16(v[6], v[7]);
                        *(u32x4*)(O + (size_t)r * 4096 + col0 + bj * 128) = w; }
            }
        } else {
#pragma unroll
            for (int ai = 0; ai < 2; ++ai)
#pragma unroll
                for (int m = 0; m < 4; ++m) { const int r = row0 + ai * 128 + m * 16; const float ri = rinv16(ssq, r); bf16* rowp = O + (size_t)r * 4096 + col0;
#pragma unroll
                    for (int bj = 0; bj < 2; ++bj) { const f32x4 v0 = acc[ai][bj][m][0] * ri, v1 = acc[ai][bj][m][1] * ri;
                        u32x4 w; w.x = cvt_pk_bf16(v0[0], v0[1]); w.y = cvt_pk_bf16(v0[2], v0[3]); w.z = cvt_pk_bf16(v1[0], v1[1]); w.w = cvt_pk_bf16(v1[2], v1[3]);
                        *(u32x4*)(rowp + bj * 128) = w; } }
        }
    }
};
struct EpiResidual {
    bf16* xb; float* ssq; float sc; int pad;
    template <class S_t> DEV void prep(LAS unsigned char*, const S_t&, int) const {}
    DEV void operator()(const f32x4 (&acc)[2][2][4][2], const pg8::Unit& u, int wr, int wc, int fr, int fq) const {
        const int row0 = u.pm * 256 + wr * 64 + fr, col0 = u.pn * 256 + wc * 32 + 8 * fq;
#pragma unroll
        for (int ai = 0; ai < 2; ++ai)
#pragma unroll
            for (int m = 0; m < 4; ++m) { const int r = row0 + ai * 128 + m * 16; float part = 0.f;
#pragma unroll
                for (int bj = 0; bj < 2; ++bj) { bf16* p = xb + (size_t)r * D + col0 + bj * 128; const u32x4 o = *(const u32x4*)p;
                    f32x4 v0 = acc[ai][bj][m][0] * sc, v1 = acc[ai][bj][m][1] * sc;
                    v0[0] += __uint_as_float(o.x << 16); v0[1] += __uint_as_float(o.x & 0xffff0000u); v0[2] += __uint_as_float(o.y << 16); v0[3] += __uint_as_float(o.y & 0xffff0000u);
                    v1[0] += __uint_as_float(o.z << 16); v1[1] += __uint_as_float(o.z & 0xffff0000u); v1[2] += __uint_as_float(o.w << 16); v1[3] += __uint_as_float(o.w & 0xffff0000u);
                    u32x4 w; w.x = cvt_pk_bf16(v0[0], v0[1]); w.y = cvt_pk_bf16(v0[2], v0[3]); w.z = cvt_pk_bf16(v1[0], v1[1]); w.w = cvt_pk_bf16(v1[2], v1[3]);
                    *(u32x4*)p = w;
                    part += ((v0[0] * v0[0] + v0[1] * v0[1]) + (v0[2] * v0[2] + v0[3] * v0[3])) + ((v1[0] * v1[0] + v1[1] * v1[1]) + (v1[2] * v1[2] + v1[3] * v1[3])); }
                part += xlane16(part, fr + 16 * fq); part += xlane32(part, fr + 16 * fq);
                if (fq == 0) ssq[(size_t)r * 16 + u.pn * 4 + wc] = part; }
    }
};
struct EpiQG {
    bf16* Q; float* gates; const float* ssq;
    template <class S_t> DEV void prep(LAS unsigned char*, const S_t&, int) const {}
    DEV void operator()(const f32x4 (&acc)[2][2][4][2], const pg8::Unit& u, int wr, int wc, int fr, int fq) const {
        const int row0 = u.pm * 256 + wr * 64 + fr, cl = wc * 32 + 8 * fq;
        float ri8[8]; rinv8(ssq, row0, fr, fq, ri8);
        if (u.pn < 4) {
#pragma unroll
            for (int ai = 0; ai < 2; ++ai)
#pragma unroll
                for (int m = 0; m < 4; ++m) { const int r = row0 + ai * 128 + m * 16; const float ri = ri8[4 * ai + m];
#pragma unroll
                    for (int bj = 0; bj < 2; ++bj) { const f32x4 v0 = acc[ai][bj][m][0] * ri, v1 = acc[ai][bj][m][1] * ri;
                        u32x4 w; w.x = cvt_pk_bf16(v0[0], v0[1]); w.y = cvt_pk_bf16(v0[2], v0[3]); w.z = cvt_pk_bf16(v1[0], v1[1]); w.w = cvt_pk_bf16(v1[2], v1[3]);
                        *(u32x4*)(Q + (size_t)r * D + u.pn * 256 + cl + bj * 128) = w; } }
        } else if (cl < 48) {
#pragma unroll
            for (int ai = 0; ai < 2; ++ai)
#pragma unroll
                for (int m = 0; m < 4; ++m) { const int r = row0 + ai * 128 + m * 16; const float ri = ri8[4 * ai + m];
                    const f32x4 v0 = acc[ai][0][m][0] * ri, v1 = acc[ai][0][m][1] * ri; f32x4 g0, g1;
#pragma unroll
                    for (int e = 0; e < 4; ++e) { g0[e] = 1.0f / (1.0f + __expf(-v0[e])); g1[e] = 1.0f / (1.0f + __expf(-v1[e])); }
                    float* gp = gates + (size_t)r * 48 + cl; *(f32x4*)gp = g0; *(f32x4*)(gp + 4) = g1; }
        }
    }
};


namespace hg {
typedef short s16x4 __attribute__((ext_vector_type(4)));
typedef float f32x2_t __attribute__((ext_vector_type(2))); typedef __bf16 bf16x2_t __attribute__((ext_vector_type(2)));
constexpr int SEGCH = 8, NSEG = T / (64 * SEGCH);
constexpr int L_QT = 0, L_KT = 16384, L_V = 32768, L_ATT = 49152, L_EB = 57344, L_CR = 57856, L_CT = 58368, L_RED = 58880;
DEV unsigned cvtpk(float lo, float hi) { f32x2_t v = {lo, hi}; bf16x2_t b = __builtin_convertvector(v, bf16x2_t); return __builtin_bit_cast(unsigned, b); }
DEV int toff(int row, int col) { return row * 256 + ((((col >> 3) ^ row) & 15) << 4) + (col & 7) * 2; }
DEV int aoff(int t, int s) { return t * 128 + ((((s >> 2) ^ t) & 15) << 3); }
DEV s16x4 trr(LAS unsigned char* p) { return __builtin_bit_cast(s16x4, __builtin_amdgcn_ds_read_tr16_b64_v4i16((LAS s16x4*)p)); }
DEV bf16x8 cat(s16x4 a, s16x4 b) { return __builtin_shufflevector(a, b, 0, 1, 2, 3, 4, 5, 6, 7); }
DEV f32x4 mfma16(bf16x8 a, bf16x8 b, f32x4 c) { return __builtin_amdgcn_mfma_f32_16x16x32_bf16(a, b, c, 0, 0, 0); }
DEV f32x4 mfma16z(bf16x8 a, bf16x8 b) { return __builtin_amdgcn_mfma_f32_16x16x32_bf16(a, b, (f32x4){0.f, 0.f, 0.f, 0.f}, 0, 0, 0); }
template <int CTRL, int RM> DEV float dppadd(float x) { return x + __builtin_bit_cast(float, __builtin_amdgcn_update_dpp(0, __builtin_bit_cast(int, x), CTRL, RM, 0xf, false)); }
DEV float wscan(float x) {
    x = dppadd<0x111, 0xf>(x); x = dppadd<0x112, 0xf>(x); x = dppadd<0x114, 0xf>(x); x = dppadd<0x118, 0xf>(x);
    x = dppadd<0x142, 0xa>(x); x = dppadd<0x143, 0xc>(x); return x;
}
#define WSCAN16_STEP(CTRL) asm volatile("s_nop 1\n\t" \
    "v_add_f32_dpp %0, %0, %0 " CTRL "\n\tv_add_f32_dpp %1, %1, %1 " CTRL "\n\tv_add_f32_dpp %2, %2, %2 " CTRL "\n\tv_add_f32_dpp %3, %3, %3 " CTRL "\n\t" \
    "v_add_f32_dpp %4, %4, %4 " CTRL "\n\tv_add_f32_dpp %5, %5, %5 " CTRL "\n\tv_add_f32_dpp %6, %6, %6 " CTRL "\n\tv_add_f32_dpp %7, %7, %7 " CTRL "\n\t" \
    "v_add_f32_dpp %8, %8, %8 " CTRL "\n\tv_add_f32_dpp %9, %9, %9 " CTRL "\n\tv_add_f32_dpp %10, %10, %10 " CTRL "\n\tv_add_f32_dpp %11, %11, %11 " CTRL "\n\t" \
    "v_add_f32_dpp %12, %12, %12 " CTRL "\n\tv_add_f32_dpp %13, %13, %13 " CTRL "\n\tv_add_f32_dpp %14, %14, %14 " CTRL "\n\tv_add_f32_dpp %15, %15, %15 " CTRL \
    : "+v"(x[0]), "+v"(x[1]), "+v"(x[2]), "+v"(x[3]), "+v"(x[4]), "+v"(x[5]), "+v"(x[6]), "+v"(x[7]), "+v"(x[8]), "+v"(x[9]), "+v"(x[10]), "+v"(x[11]), "+v"(x[12]), "+v"(x[13]), "+v"(x[14]), "+v"(x[15]))
DEV void wscan16(float (&x)[16]) {
    WSCAN16_STEP("row_shr:1 row_mask:0xf bank_mask:0xf"); WSCAN16_STEP("row_shr:2 row_mask:0xf bank_mask:0xf"); WSCAN16_STEP("row_shr:4 row_mask:0xf bank_mask:0xf"); WSCAN16_STEP("row_shr:8 row_mask:0xf bank_mask:0xf");
    WSCAN16_STEP("row_bcast:15 row_mask:0xa bank_mask:0xf"); WSCAN16_STEP("row_bcast:31 row_mask:0xc bank_mask:0xf");
}
DEV float clo(float x, float lo) { return __builtin_amdgcn_fmed3f(x, lo, 3.0e38f); }
DEV float chi(float x, float hi) { return __builtin_amdgcn_fmed3f(x, -3.0e38f, hi); }
DEV float lo16(unsigned w) { return __uint_as_float(w << 16); }
DEV float hi16(unsigned w) { return __uint_as_float(w & 0xffff0000u); }

DEV void scan(float* hst, const float* bseg, int gid) {
    if (gid >= 32768) return;
    const int lane = gid & 63, tile = (gid >> 6) & 7, hw = gid >> 9, h = hw >> 3, g = lane >> 4;
    f32x4 run = (f32x4){0.f, 0.f, 0.f, 0.f};
#pragma unroll 1
    for (int j0 = 0; j0 < NSEG; j0 += 8) {
        f32x4 L[8], B[8];
#pragma unroll
        for (int j = 0; j < 8; ++j) if (j0 + j < NSEG - 1) { L[j] = *(const f32x4*)(hst + ((size_t)(j0 + j) * 32768 + gid) * 4); B[j] = *(const f32x4*)(bseg + (size_t)((j0 + j) * 8 + h) * 128 + 16 * tile + 4 * g); }
#pragma unroll
        for (int j = 0; j < 8; ++j) {
            *(f32x4*)(hst + ((size_t)(j0 + j) * 32768 + gid) * 4) = run;
            if (j0 + j < NSEG - 1) {
#pragma unroll
                for (int e = 0; e < 4; ++e) run[e] = fmaf(run[e], __builtin_amdgcn_exp2f(B[j][e]), L[j][e]); }
        }
    }
}

constexpr int H_SET = 49152, H_Q = 0, H_K = 16384, H_V = 32768, H_ATT = 98304, H_VEC = 106496  , H_RED = 109568;
DEV void tile_in(LAS unsigned char* tile, const bf16* src, int wid, int lane) {
#pragma unroll
    for (int j = 0; j < 2; ++j) { const int row = 8 * wid + 4 * j + (lane >> 4), ch = (lane ^ row) & 15;
        __builtin_amdgcn_global_load_lds((const unsigned*)(src + (size_t)row * 4096 + ch * 8), (LAS unsigned*)(tile + (8 * wid + 4 * j) * 256), 16, 0, 0); }
}
DEV void tile_out(LAS unsigned char* tile, bf16* dst, int wid, int lane) {
#pragma unroll
    for (int j = 0; j < 2; ++j) { const int row = 8 * wid + 4 * j + (lane >> 4), ch = (lane ^ row) & 15;
        *(u32x4*)(dst + (size_t)row * 4096 + ch * 8) = *(const LAS u32x4*)(tile + (8 * wid + 4 * j) * 256 + lane * 16); }
}
#define HG_BAR() do { asm volatile("s_waitcnt lgkmcnt(0)" ::: "memory"); __builtin_amdgcn_s_barrier(); asm volatile("" ::: "memory"); } while (0)

DEV void pass1(LAS unsigned char* lds, bf16* proj, float* hst, float* bseg, float* aux, const float* __restrict__ lbp, int layer, int bid, int nblk, const int tid, const bool do_store) {
    const int wid = __builtin_amdgcn_readfirstlane(tid >> 6), lane0 = tid & 63;
    for (int item = bid; item < 8 * NSEG; item += nblk) {
        const int h = item & 7, seg = item >> 3;
        float lbv[16];
#pragma unroll
        for (int cc = 0; cc < 16; ++cc) { lbv[cc] = 0.f; if (layer == 1) { const int ch = h * 128 + 16 * wid + cc; lbv[cc] = 1.0f / (1.0f + __expf(lbp[ch] - lbp[1024 + ch])); } }
        f32x4 S[8];
#pragma unroll
        for (int i = 0; i < 8; ++i) S[i] = (f32x4){0.f, 0.f, 0.f, 0.f};
        float segB[16];
#pragma unroll
        for (int cc = 0; cc < 16; ++cc) segB[cc] = 0.f;
        bf16* const pbase = proj + (size_t)(seg * SEGCH * 64) * 4096 + h * 128;
        __syncthreads();
        tile_in(lds + H_Q, pbase, wid, lane0); tile_in(lds + H_K, pbase + 1024, wid, lane0); tile_in(lds + H_V, pbase + 2048, wid, lane0);
        for (int c = 0; c < SEGCH; ++c) {
            const int t0 = (seg * SEGCH + c) * 64;
            int lane = lane0; asm volatile("" : "+v"(lane));
            const int r16 = lane & 15, g = lane >> 4, q4 = r16 >> 2, p4 = r16 & 3;
            LAS unsigned char* const set = lds + (c & 1) * H_SET; LAS unsigned char* const vec = lds + H_VEC + (c & 1) * 1536;
            asm volatile("s_waitcnt vmcnt(0)" ::: "memory");
            HG_BAR();
            if (c + 1 < SEGCH) { LAS unsigned char* nset = lds + ((c + 1) & 1) * H_SET; const bf16* nb = pbase + (size_t)(c + 1) * 64 * 4096;
                tile_in(nset + H_Q, nb, wid, lane); tile_in(nset + H_K, nb + 1024, wid, lane); tile_in(nset + H_V, nb + 2048, wid, lane); }
            {
                float x[16], kk[16], qq[16], ee[16], eb[16];
                const int o0 = lane * 256 + ((((2 * wid) ^ lane) & 15) << 4), o1 = lane * 256 + ((((2 * wid + 1) ^ lane) & 15) << 4);
                const u32x4 f0 = *(const LAS u32x4*)(set + H_K + o0), f1 = *(const LAS u32x4*)(set + H_K + o1), q0 = *(const LAS u32x4*)(set + H_Q + o0), q1 = *(const LAS u32x4*)(set + H_Q + o1);
                const unsigned fw[8] = {f0.x, f0.y, f0.z, f0.w, f1.x, f1.y, f1.z, f1.w};
                const unsigned qw[8] = {q0.x, q0.y, q0.z, q0.w, q1.x, q1.y, q1.z, q1.w};
#pragma unroll
                for (int e = 0; e < 8; ++e) { x[2 * e] = lo16(fw[e]); x[2 * e + 1] = hi16(fw[e]); qq[2 * e] = lo16(qw[e]); qq[2 * e + 1] = hi16(qw[e]); }
#pragma unroll
                for (int cc = 0; cc < 16; ++cc) {
                    const float sg = __builtin_amdgcn_rcpf(1.0f + __builtin_amdgcn_exp2f(-1.4426950408889634f * x[cc]));
                    const float ff = clo(fmaf(1.0f - lbv[cc], sg, lbv[cc]), 1e-30f);
                    kk[cc] = 1.0f - ff;
                    x[cc] = __builtin_amdgcn_logf(ff);
                }
                wscan16(x);
#pragma unroll
                for (int cc = 0; cc < 16; ++cc) {
                    const float refc = clo(__builtin_bit_cast(float, __builtin_amdgcn_readlane(__builtin_bit_cast(int, x[cc]), 31)), -100.f);
                    ee[cc] = __builtin_amdgcn_exp2f(chi(x[cc] - refc, 100.f));
                    kk[cc] *= __builtin_amdgcn_exp2f(chi(refc - x[cc], 100.f)); qq[cc] *= ee[cc];
                    eb[cc] = __builtin_amdgcn_exp2f(x[cc]);
                }
                float* auxp = aux + ((size_t)((seg * SEGCH + c) * 8 + h) * 3) * 128 + 16 * wid;
                if (lane == 63) {
#pragma unroll
                    for (int j = 0; j < 4; ++j) { const f32x4 e4 = {eb[4 * j], eb[4 * j + 1], eb[4 * j + 2], eb[4 * j + 3]}, c4 = {ee[4 * j], ee[4 * j + 1], ee[4 * j + 2], ee[4 * j + 3]};
                        *(LAS f32x4*)(vec + (16 * wid + 4 * j) * 4) = e4; *(LAS f32x4*)(vec + 1024 + (16 * wid + 4 * j) * 4) = c4;
                        *(f32x4*)(auxp + 4 * j) = e4; *(f32x4*)(auxp + 256 + 4 * j) = c4; }
#pragma unroll
                    for (int cc = 0; cc < 16; ++cc) segB[cc] += x[cc];
                }
                if (lane == 31) {
#pragma unroll
                    for (int j = 0; j < 4; ++j) *(f32x4*)(auxp + 128 + 4 * j) = (f32x4){eb[4 * j], eb[4 * j + 1], eb[4 * j + 2], eb[4 * j + 3]};
                }
                unsigned kw[8], qw2[8];
#pragma unroll
                for (int e = 0; e < 8; ++e) { kw[e] = cvtpk(kk[2 * e], kk[2 * e + 1]); qw2[e] = cvtpk(qq[2 * e], qq[2 * e + 1]); }
                *(LAS u32x4*)(set + H_K + o0) = (u32x4){kw[0], kw[1], kw[2], kw[3]}; *(LAS u32x4*)(set + H_K + o1) = (u32x4){kw[4], kw[5], kw[6], kw[7]};
                *(LAS u32x4*)(set + H_Q + o0) = (u32x4){qw2[0], qw2[1], qw2[2], qw2[3]}; *(LAS u32x4*)(set + H_Q + o1) = (u32x4){qw2[4], qw2[5], qw2[6], qw2[7]};
            }
            HG_BAR();
            if (do_store) { bf16* ob = pbase + (size_t)c * 64 * 4096; tile_out(set + H_Q, ob, wid, lane); tile_out(set + H_K, ob + 1024, wid, lane); }
            {
                f32x4 U[8];
#pragma unroll
                for (int ks = 0; ks < 2; ++ks) {
                    const int rowB = 32 * ks + 8 * g + q4, colB = 16 * wid + 4 * p4;
                    const bf16x8 B = cat(trr(set + H_V + toff(rowB, colB)), trr(set + H_V + toff(rowB + 4, colB)));
                    const int ka0 = toff(rowB, 4 * p4), ka1 = toff(rowB + 4, 4 * p4);
#pragma unroll
                    for (int i = 0; i < 8; ++i) {
                        const bf16x8 A = cat(trr(set + H_K + (ka0 ^ (i << 5))), trr(set + H_K + (ka1 ^ (i << 5))));
                        U[i] = ks == 0 ? mfma16z(A, B) : mfma16(A, B, U[i]); }
                }
#pragma unroll
                for (int i = 0; i < 8; ++i) { const f32x4 e = *(const LAS f32x4*)(vec + (16 * i + 4 * g) * 4), ct = *(const LAS f32x4*)(vec + 1024 + (16 * i + 4 * g) * 4); S[i] = S[i] * e + U[i] * ct; }
            }
        }
        float* Ls = hst + ((size_t)((seg * 8 + h) * 8 + wid) * 8) * 256 + lane0 * 4;
#pragma unroll
        for (int i = 0; i < 8; ++i) *(f32x4*)(Ls + i * 256) = S[i];
        if (lane0 == 63) {
#pragma unroll
            for (int cc = 0; cc < 16; ++cc) bseg[(size_t)(seg * 8 + h) * 128 + 16 * wid + cc] = segB[cc];
        }
    }
}

DEV void pass2(LAS unsigned char* lds, bf16* proj, const float* hst, const float* aux, const float* __restrict__ gw, int bid, int nblk, const int tid, bf16* oproj, int old) {
    const int wid = __builtin_amdgcn_readfirstlane(tid >> 6), lane0 = tid & 63;
    for (int item = bid; item < 8 * NSEG; item += nblk) {
        const int h = item & 7, seg = item >> 3;
        f32x4 S[8];
        {
            const float* Ls = hst + ((size_t)((seg * 8 + h) * 8 + wid) * 8) * 256 + lane0 * 4;
#pragma unroll
            for (int i = 0; i < 8; ++i) S[i] = *(const f32x4*)(Ls + i * 256);
        }
        const f32x4 gw4 = *(const f32x4*)(gw + 16 * wid + 4 * (lane0 >> 4));
        const bf16* const pbase = proj + (size_t)(seg * SEGCH * 64) * 4096 + h * 128;
        f32x4 pa = (f32x4){0.f, 0.f, 0.f, 0.f};
        __syncthreads();
        tile_in(lds + H_Q, pbase, wid, lane0); tile_in(lds + H_K, pbase + 1024, wid, lane0); tile_in(lds + H_V, pbase + 2048, wid, lane0);
        if (tid < 96) pa = *(const f32x4*)(aux + ((size_t)((seg * SEGCH) * 8 + h) * 3) * 128 + 4 * tid);
        for (int c = 0; c < SEGCH; ++c) {
            const int t0 = (seg * SEGCH + c) * 64;
            int lane = lane0; asm volatile("" : "+v"(lane));
            const int r16 = lane & 15, g = lane >> 4, q4 = r16 >> 2, p4 = r16 & 3;
            const int TY = (g ^ r16) & 15;
            const int TQ = r16 * 256 + (TY << 4);
            const int TH = r16 * 256 + ((((g >> 1) ^ r16) & 15) << 4) + 8 * (g & 1);
            const int TA = r16 * 128 + (TY << 3);
            LAS unsigned char* const set = lds + (c & 1) * H_SET; LAS unsigned char* const vec = lds + H_VEC + (c & 1) * 1536;
            asm volatile("s_waitcnt vmcnt(0)" ::: "memory");
            if (tid < 96) *(LAS f32x4*)(vec + 16 * tid) = pa;
            HG_BAR();
            if (c + 1 < SEGCH) { LAS unsigned char* nset = lds + ((c + 1) & 1) * H_SET; const bf16* nb = pbase + (size_t)(c + 1) * 64 * 4096;
                tile_in(nset + H_Q, nb, wid, lane); tile_in(nset + H_K, nb + 1024, wid, lane); tile_in(nset + H_V, nb + 2048, wid, lane);
                if (tid < 96) pa = *(const f32x4*)(aux + ((size_t)((seg * SEGCH + c + 1) * 8 + h) * 3) * 128 + 4 * tid); }
            uint2 gv[4];
#pragma unroll
            for (int tt = 0; tt < 4; ++tt) gv[tt] = *(const uint2*)(proj + (size_t)(t0 + 16 * tt + r16) * 4096 + 3072 + h * 128 + 16 * wid + 4 * g);
            f32x4 O[4];
#pragma unroll
            for (int i = 0; i < 2; ++i) {
                const int idx = 2 * wid + i, st = idx >> 2, tt = idx & 3; unsigned w0 = 0u, w1 = 0u;
                if (st <= tt) {
                    f32x4 a;
#pragma unroll
                    for (int ks = 0; ks < 4; ++ks) {
                        const bf16x8 A = *(const LAS bf16x8*)(set + H_K + 4096 * st + (TQ ^ (ks << 6)));
                        const bf16x8 B = *(const LAS bf16x8*)(set + H_Q + 4096 * tt + (TQ ^ (ks << 6)));
                        a = ks == 0 ? mfma16z(A, B) : mfma16(A, B, a);
                    }
                    if (st == tt) {
#pragma unroll
                        for (int e = 0; e < 4; ++e) a[e] = (4 * g + e > r16) ? 0.f : a[e];
                    }
                    w0 = cvtpk(a[0], a[1]); w1 = cvtpk(a[2], a[3]);
                }
                const int t = 16 * tt + r16;
                { typedef unsigned u32x2 __attribute__((ext_vector_type(2))); *(LAS u32x2*)(lds + H_ATT + aoff(t, 16 * st + 4 * g)) = (u32x2){w0, w1}; }
            }
            HG_BAR();
#pragma unroll
            for (int ks = 0; ks < 4; ++ks) {
                const f32x4 c0 = *(const LAS f32x4*)(vec + 512 + (32 * ks + 4 * g) * 4), c1 = *(const LAS f32x4*)(vec + 512 + (32 * ks + 16 + 4 * g) * 4);
                u32x4 sw; sw.x = cvtpk(S[2 * ks][0] * c0[0], S[2 * ks][1] * c0[1]); sw.y = cvtpk(S[2 * ks][2] * c0[2], S[2 * ks][3] * c0[3]);
                sw.z = cvtpk(S[2 * ks + 1][0] * c1[0], S[2 * ks + 1][1] * c1[1]); sw.w = cvtpk(S[2 * ks + 1][2] * c1[2], S[2 * ks + 1][3] * c1[3]);
                const bf16x8 A = __builtin_bit_cast(bf16x8, sw);
#pragma unroll
                for (int tt = 0; tt < 4; ++tt) { const int t = 16 * tt + r16;
                    const s16x4 b0 = *(const volatile LAS s16x4*)(set + H_Q + 4096 * tt + (TH ^ (ks << 6))), b1 = *(const volatile LAS s16x4*)(set + H_Q + 4096 * tt + (TH ^ 32 ^ (ks << 6)));
                    O[tt] = ks == 0 ? mfma16z(A, cat(b0, b1)) : mfma16(A, cat(b0, b1), O[tt]); }
            }
#pragma unroll
            for (int ks = 0; ks < 2; ++ks) {
                const int rowA = 32 * ks + 4 * g + q4, colA = 16 * wid + 4 * p4;
                const bf16x8 A = cat(trr(set + H_V + toff(rowA, colA)), trr(set + H_V + toff(rowA + 16, colA)));
#pragma unroll
                for (int tt = 0; tt < 4; ++tt) if (32 * ks <= 16 * tt + 15) { const int t = 16 * tt + r16;
                    const s16x4 b0 = *(const volatile LAS s16x4*)(lds + H_ATT + 2048 * tt + (TA ^ (ks << 6))), b1 = *(const volatile LAS s16x4*)(lds + H_ATT + 2048 * tt + (TA ^ 32 ^ (ks << 6)));
                    O[tt] = mfma16(A, cat(b0, b1), O[tt]); }
            }
            {
                f32x4 U[8];
#pragma unroll
                for (int ks = 0; ks < 2; ++ks) {
                    const int rowB = 32 * ks + 8 * g + q4, colB = 16 * wid + 4 * p4;
                    const bf16x8 B = cat(trr(set + H_V + toff(rowB, colB)), trr(set + H_V + toff(rowB + 4, colB)));
                    const int ka0 = toff(rowB, 4 * p4), ka1 = toff(rowB + 4, 4 * p4);
#pragma unroll
                    for (int i = 0; i < 8; ++i) {
                        const bf16x8 A = cat(trr(set + H_K + (ka0 ^ (i << 5))), trr(set + H_K + (ka1 ^ (i << 5))));
                        U[i] = ks == 0 ? mfma16z(A, B) : mfma16(A, B, U[i]); }
                }
#pragma unroll
                for (int i = 0; i < 8; ++i) { const f32x4 e = *(const LAS f32x4*)(vec + (16 * i + 4 * g) * 4), ct = *(const LAS f32x4*)(vec + 1024 + (16 * i + 4 * g) * 4); S[i] = S[i] * e + U[i] * ct; }
            }
            LAS float* red = (LAS float*)(lds + H_RED);
            { float p[4];
#pragma unroll
              for (int tt = 0; tt < 4; ++tt) p[tt] = (O[tt][0] * O[tt][0] + O[tt][1] * O[tt][1]) + (O[tt][2] * O[tt][2] + O[tt][3] * O[tt][3]);
              const float tot = swapadd32(swapadd16(p[0], p[1]), swapadd16(p[2], p[3]));
              red[wid * 64 + 4 * r16 + g] = tot; }
            HG_BAR();
            f32x4 ss = *(const LAS f32x4*)(red + 4 * r16);
#pragma unroll
            for (int w = 1; w < 8; ++w) ss = ss + *(const LAS f32x4*)(red + w * 64 + 4 * r16);
#pragma unroll
            for (int tt = 0; tt < 4; ++tt) { const int t = 16 * tt + r16; const float ssum = ss[tt];
                const float ri = rsqrtf(ssum * (1.0f / 128.0f) + EPS);
                const float g0 = lo16(gv[tt].x), g1 = hi16(gv[tt].x), g2 = lo16(gv[tt].y), g3 = hi16(gv[tt].y);
                const float o0 = O[tt][0] * ri * gw4[0] * g0 * __builtin_amdgcn_rcpf(1.0f + __expf(-g0)), o1 = O[tt][1] * ri * gw4[1] * g1 * __builtin_amdgcn_rcpf(1.0f + __expf(-g1));
                const float o2 = O[tt][2] * ri * gw4[2] * g2 * __builtin_amdgcn_rcpf(1.0f + __expf(-g2)), o3 = O[tt][3] * ri * gw4[3] * g3 * __builtin_amdgcn_rcpf(1.0f + __expf(-g3));
                *(uint2*)(oproj + (size_t)(t0 + t) * old + h * 128 + 16 * wid + 4 * g) = make_uint2(cvtpk(o0, o1), cvtpk(o2, o3)); }
        }
    }
}
}

namespace nsa {
typedef float f32x16 __attribute__((ext_vector_type(16)));
typedef short s16x4 __attribute__((ext_vector_type(4)));
typedef float f32x2_t __attribute__((ext_vector_type(2))); typedef __bf16 bf16x2_t __attribute__((ext_vector_type(2)));
constexpr int IMPS = 264, IMPP = 132;
constexpr int L_IMP = 0, L_KV = 67584, L_SELB = 100352, L_WUN = 102400, L_BL = 102656, L_NB = 103744;
constexpr float NINF = -__builtin_inff();
DEV unsigned cvtpk(float lo, float hi) { f32x2_t v = {lo, hi}; bf16x2_t b = __builtin_convertvector(v, bf16x2_t); return __builtin_bit_cast(unsigned, b); }
DEV f32x16 mfma32(bf16x8 a, bf16x8 b, f32x16 c) { return __builtin_amdgcn_mfma_f32_32x32x16_bf16(a, b, c, 0, 0, 0); }
DEV s16x4 trr(LAS unsigned char* p) { return __builtin_bit_cast(s16x4, __builtin_amdgcn_ds_read_tr16_b64_v4i16((LAS s16x4*)p)); }
DEV bf16x8 cat(s16x4 a, s16x4 b) { return __builtin_shufflevector(a, b, 0, 1, 2, 3, 4, 5, 6, 7); }
DEV float ex2(float x) { return __builtin_amdgcn_exp2f(x); }
DEV float xhalf(float x, int lane) {
    const auto r = __builtin_amdgcn_permlane32_swap(__builtin_bit_cast(unsigned, x), __builtin_bit_cast(unsigned, x), false, false);
    return __builtin_bit_cast(float, lane < 32 ? r[1] : r[0]); }

template <bool WV> DEV void stage(LAS unsigned char* slot, const bf16* kbase, long vdelta, int stride, int wid, int lane) {
    const int row = 8 * wid + (lane >> 3), ch = (lane ^ (row >> 1)) & 7;
    const unsigned lo = (unsigned)(row * stride + ch * 8) * 2u;
    const char* kp = (const char*)kbase + lo;
    __builtin_amdgcn_global_load_lds((const unsigned*)kp, (LAS unsigned*)(slot + wid * 1024), 16, 0, 0);
    if (WV) __builtin_amdgcn_global_load_lds((const unsigned*)(kp + vdelta), (LAS unsigned*)(slot + 8192 + wid * 1024), 16, 0, 0);
}

template <int CTRL> DEV float dppf(float x) { return __builtin_bit_cast(float, __builtin_amdgcn_update_dpp(0, __builtin_bit_cast(int, x), CTRL, 0xf, 0xf, true)); }
template <int CTRL> DEV unsigned dppu(unsigned x) { return (unsigned)__builtin_amdgcn_update_dpp(0, (int)x, CTRL, 0xf, 0xf, true); }
struct St { float m, l; unsigned nmw; int seen; f32x16 O0, O1; float carry; };
DEV unsigned split2(float x) { const unsigned w0 = cvtpk(x, 0.f); const float hf = __uint_as_float(w0 << 16); return (w0 & 0xffffu) | (cvtpk(x - hf, 0.f) << 16); }
DEV unsigned pk2(float x) { return cvtpk(x, x); }

template <int MODE, bool FAST = false>
DEV bool block(LAS unsigned char* slot, const bf16x8 (&qf)[4], unsigned qsl, unsigned kd0, unsigned kd1, const unsigned (&kl)[2], unsigned hz, bool member,
               bool need_mask, bool two_sided, int lo, int hi_, St& st, LAS float* imp, int tokrow, int nsbase, int lane) {
    const int key0 = lane & 31, hi = lane >> 5;
    f32x16 s0, s1;
    {
        bf16x8 ka[4][2];
#pragma unroll
        for (int ks = 0; ks < 4; ++ks) { const int off = key0 * 128 + ((((2 * ks + hi) ^ (key0 >> 1)) & 7) << 4);
            ka[ks][0] = *(const LAS bf16x8*)(slot + off); ka[ks][1] = *(const LAS bf16x8*)(slot + 4096 + off); }
        const u32x4 qa = {qsl, qsl, qsl, member ? st.nmw : 0x0000c6eau  };
        const u32x4 k0 = {kd0 & hz, kd1 & hz, kl[0] & hz, 0x3f803f80u & hz}, k1 = {kd0 & hz, kd1 & hz, kl[1] & hz, 0x3f803f80u & hz};
        __builtin_amdgcn_sched_barrier(0);
        f32x16 z;
#pragma unroll
        for (int r = 0; r < 16; ++r) z[r] = 0.f;
        s0 = mfma32(__builtin_bit_cast(bf16x8, k0), __builtin_bit_cast(bf16x8, qa), z); s1 = mfma32(__builtin_bit_cast(bf16x8, k1), __builtin_bit_cast(bf16x8, qa), z);
#pragma unroll
        for (int ks = 0; ks < 4; ++ks) { s0 = mfma32(ka[ks][0], qf[ks], s0); s1 = mfma32(ka[ks][1], qf[ks], s1); }
    }
    bf16x8 va[2][2][2];
    if (MODE == 0 || MODE == 3) {
        const int i16 = lane & 15, q4 = i16 >> 2, p4 = i16 & 3, dsub = (lane >> 4) & 1;
#pragma unroll
        for (int tau = 0; tau < 2; ++tau)
#pragma unroll
            for (int s = 0; s < 2; ++s) { const int row = 32 * tau + 16 * s + 4 * hi + q4;
#pragma unroll
                for (int dt = 0; dt < 2; ++dt) { const int col = 32 * dt + 16 * dsub + 4 * p4;
                    const int o0 = 8192 + row * 128 + ((((col >> 3) ^ (row >> 1)) & 7) << 4) + ((col >> 2) & 1) * 8;
                    const int o1 = 8192 + (row + 8) * 128 + ((((col >> 3) ^ ((row + 8) >> 1)) & 7) << 4) + ((col >> 2) & 1) * 8;
                    va[tau][s][dt] = cat(trr(slot + o0), trr(slot + o1)); } }
    }
    __builtin_amdgcn_sched_barrier(0);
    if (need_mask) {
        const int lo2 = lo - 4 * hi, hi2 = hi_ - 4 * hi;
        if (!two_sided) {
#pragma unroll
            for (int r = 0; r < 16; ++r) { const int c0 = (r & 3) + 8 * (r >> 2);
                s0[r] = (c0 <= hi2) ? s0[r] : NINF; s1[r] = (c0 + 32 <= hi2) ? s1[r] : NINF; }
        } else {
#pragma unroll
            for (int r = 0; r < 16; ++r) { const int c0 = (r & 3) + 8 * (r >> 2), c1 = c0 + 32;
                s0[r] = (c0 >= lo2 && c0 <= hi2) ? s0[r] : NINF; s1[r] = (c1 >= lo2 && c1 <= hi2) ? s1[r] : NINF; }
        }
    }
    if ((MODE == 0 || MODE == 2) && FAST) {
        float ls = 0.f;
#pragma unroll
        for (int r = 0; r < 16; ++r) { s0[r] = ex2(s0[r]); s1[r] = ex2(s1[r]); ls += s0[r] + s1[r]; }
        if (__any(!(ls < 65536.f) || st.seen == 0)) return true;
        st.l += ls;
    } else if (MODE == 0 || MODE == 2) {
        float m0 = s0[0], m1 = s1[0];
#pragma unroll
        for (int r = 1; r < 16; ++r) { m0 = fmaxf(m0, s0[r]); m1 = fmaxf(m1, s1[r]); }
        float mloc = fmaxf(m0, m1);
        mloc = fmaxf(mloc, xhalf(mloc, lane));
        const bool valid = mloc > -1e4f, fresh = st.seen == 0;
        const float delta = valid ? (fresh ? mloc : fmaxf(mloc, 0.f)) : 0.f;
        float alpha = 1.0f;
        if (__any(delta != 0.f)) {
            alpha = fresh ? 1.0f : ex2(-delta);
#pragma unroll
            for (int r = 0; r < 16; ++r) { s0[r] -= delta; s1[r] -= delta; }
            st.m += delta; st.nmw = split2(-st.m);
            if (MODE == 0) { if (!__all(alpha == 1.0f)) { st.O0 = st.O0 * alpha; st.O1 = st.O1 * alpha; } }
        }
        float ls = 0.f;
#pragma unroll
        for (int r = 0; r < 16; ++r) { s0[r] = ex2(s0[r]); s1[r] = ex2(s1[r]); ls += s0[r] + s1[r]; }
        st.l = st.l * alpha + ls; st.seen |= valid ? 1 : 0;
    } else {
#pragma unroll
        for (int r = 0; r < 16; ++r) { s0[r] = ex2(s0[r]); s1[r] = ex2(s1[r]); }
    }
    if (MODE == 0 || MODE == 3) {
        bf16x8 pb[2][2];
#pragma unroll
        for (int s = 0; s < 2; ++s) {
            u32x4 w0, w1;
            w0.x = cvtpk(s0[8 * s + 0], s0[8 * s + 1]); w0.y = cvtpk(s0[8 * s + 2], s0[8 * s + 3]); w0.z = cvtpk(s0[8 * s + 4], s0[8 * s + 5]); w0.w = cvtpk(s0[8 * s + 6], s0[8 * s + 7]);
            w1.x = cvtpk(s1[8 * s + 0], s1[8 * s + 1]); w1.y = cvtpk(s1[8 * s + 2], s1[8 * s + 3]); w1.z = cvtpk(s1[8 * s + 4], s1[8 * s + 5]); w1.w = cvtpk(s1[8 * s + 6], s1[8 * s + 7]);
            pb[0][s] = __builtin_bit_cast(bf16x8, w0); pb[1][s] = __builtin_bit_cast(bf16x8, w1);
        }
        __builtin_amdgcn_sched_barrier(0);
#pragma unroll
        for (int tau = 0; tau < 2; ++tau)
#pragma unroll
            for (int s = 0; s < 2; ++s) { st.O0 = mfma32(va[tau][s][0], pb[tau][s], st.O0); st.O1 = mfma32(va[tau][s][1], pb[tau][s], st.O1); }
    }
    if (MODE == 3) {
        float val[8];
        float carry = st.carry;
#pragma unroll
        for (int j = 0; j < 8; ++j) {
            const int tau = j >> 2, a = j & 3;
            const float p0 = tau ? s1[4 * a] : s0[4 * a], p1 = tau ? s1[4 * a + 1] : s0[4 * a + 1], p2 = tau ? s1[4 * a + 2] : s0[4 * a + 2], p3 = tau ? s1[4 * a + 3] : s0[4 * a + 3];
            float Q = (p0 + p1) + (p2 + p3), L = p3;
            Q += dppf<0xB1>(Q); L += dppf<0xB1>(L); Q += dppf<0x4E>(Q); L += dppf<0x4E>(L);
            const float Lx = xhalf(L, lane);
            val[j] = Q + (hi ? Lx : carry);
            carry = Lx;
        }
        st.carry = carry;
        if ((lane & 3) == 0) {
            const unsigned ip = (unsigned)(unsigned long)(imp + tokrow * IMPS + hi * IMPP + (nsbase >> 1));
            typedef float f32x4 __attribute__((ext_vector_type(4)));
            const f32x4 w0 = {val[0], val[1], val[2], val[3]}, w1 = {val[4], val[5], val[6], val[7]};
            asm volatile("ds_write_b128 %0, %1\n\tds_write_b128 %0, %2 offset:16" :: "v"(ip), "v"(w0), "v"(w1) : "memory");
        }
    }
    return false;
}

template <int NI>
DEV void topk_rounds(const LAS float* ir, int u, int cur, int nsel, unsigned& mybits) {
    unsigned sc[NI];
#pragma unroll
    for (int i = 0; i < NI; ++i) { const int ns = u + 8 * i; const float v = ir[4 * i];
        const bool forced = (ns == 0) || (ns == cur) || (ns == cur - 1);
        sc[i] = (ns <= cur && !forced) ? ((__float_as_uint(v) & 0xFFFFFE00u) | (unsigned)(256 - ns)) : 0u; }
    unsigned prev = 0xFFFFFFFFu;
    for (int r = 0; r < nsel; ++r) {
        const unsigned pm1 = prev - 1u;
        unsigned mn = pm1 - sc[0];
#pragma unroll
        for (int i = 1; i < NI; ++i) { const unsigned d = pm1 - sc[i]; mn = mn < d ? mn : d; }
        { unsigned o = dppu<0xB1>(mn); mn = mn < o ? mn : o; o = dppu<0x4E>(mn); mn = mn < o ? mn : o; o = dppu<0x141>(mn); mn = mn < o ? mn : o; }
        const unsigned mx = pm1 - mn; prev = mx;
        const int wns = 256 - (int)(mx & 0x1FFu);
        if ((wns & 7) == u) mybits |= 1u << (wns >> 3);
    }
}

DEV void phase(LAS unsigned char* lds, bf16* qb, const float* __restrict__ gates, const bf16* __restrict__ kv, const bf16* __restrict__ cmp, int bid, int nblk, const int tid0, bf16* qout, const int skipm, unsigned* ctr) {
    const int wid = __builtin_amdgcn_readfirstlane(tid0 >> 6);
    LAS float* imp = (LAS float*)(lds + L_IMP);
    LAS unsigned* selb = (LAS unsigned*)(lds + L_SELB);
    LAS unsigned* wun = (LAS unsigned*)(lds + L_WUN);
    LAS int* blist = (LAS int*)(lds + L_BL);
    LAS int* nbp = (LAS int*)(lds + L_NB);
    const long vcd = (long)NG * NCMP * 64 * 2;
#define NSA_SLOT(p) (lds + L_KV + ((p) & 1) * 16384)
#define NSA_STAGE_ITEM_FIRST(ITEM, SLOTP, LANE) do { const int g_ = (ITEM) & 3, qt_ = 255 - ((ITEM) >> 2); const int tl_ = 64 * qt_ + 63; const int nct_ = (skipm & 1) ? 0 : (tl_ >= 31 ? (((tl_ - 31) >> 4) >> 6) + 1 : 0); \
        if (nct_ > 0) stage<true>(SLOTP, cmp + (size_t)g_ * NCMP * 64 + (size_t)(nct_ - 1) * 4096, vcd, 64, wid, LANE); \
        else stage<true>(SLOTP, kv + 2 * 256 + g_ * 64 + (size_t)qt_ * 64 * KVW, 512, KVW, wid, LANE); } while (0)
    int sp = 0;
    if (bid < 1024) NSA_STAGE_ITEM_FIRST(bid, NSA_SLOT(0), (tid0 & 63));
    LAS int* nxtp = (LAS int*)(lds + L_NB + 4);
    int item = bid;
    while (item < 1024) {
        int tid = tid0; asm volatile("" : "+v"(tid));
        const int lane = tid & 63, n = lane & 31, hi = lane >> 5;
        const int g = item & 3, qt = 255 - (item >> 2), cur = qt;
        const int tok = 8 * wid + (n >> 2), t = 64 * qt + tok, tl = tok, head = 4 * g + (n & 3);
        const float sl2 = ex2(-0.5f * (float)(head + 1)) * 1.4426950408889634f;
        bf16x8 qf[4];
        {
            const bf16* qp = qb + (size_t)t * D + head * 64 + 8 * hi;
#pragma unroll
            for (int ks = 0; ks < 4; ++ks) { const u32x4 w = *(const u32x4*)(qp + 16 * ks); const float sc = 0.125f * 1.4426950408889634f; u32x4 o;
                o.x = cvtpk(__uint_as_float(w.x << 16) * sc, __uint_as_float(w.x & 0xffff0000u) * sc); o.y = cvtpk(__uint_as_float(w.y << 16) * sc, __uint_as_float(w.y & 0xffff0000u) * sc);
                o.z = cvtpk(__uint_as_float(w.z << 16) * sc, __uint_as_float(w.z & 0xffff0000u) * sc); o.w = cvtpk(__uint_as_float(w.w << 16) * sc, __uint_as_float(w.w & 0xffff0000u) * sc);
                qf[ks] = __builtin_bit_cast(bf16x8, o); }
        }
        const float* gp = gates + (size_t)t * 48 + head * 3;
        const float gt0 = gp[0], gt1 = gp[1], gt2 = gp[2];
        f32x16 out0, out1;
#pragma unroll
        for (int r = 0; r < 16; ++r) { out0[r] = 0.f; out1[r] = 0.f; }
        St st;
        const unsigned hz = hi ? 0u : 0xffffffffu, qsl = split2(-sl2);
        const int key0 = lane & 31;
        unsigned kl[2];
        __syncthreads();
        const int tlast = 64 * qt + 63;
        const int nct = (skipm & 1) ? 0 : (tlast >= 31 ? (((tlast - 31) >> 4) >> 6) + 1 : 0);
        const bf16* kc = cmp + (size_t)g * NCMP * 64; const bf16* ks = kv + 2 * 256 + g * 64; const bf16* kw = kv + 4 * 256 + g * 64;
        const int cmax = (t - 31) >> 4;
        kl[0] = pk2(-16.f * (float)key0); kl[1] = pk2(-16.f * (float)(key0 + 32));
        st.m = 0.f; st.l = 0.f; st.nmw = 0u; st.seen = 0; st.carry = 0.f;
#pragma unroll
        for (int r = 0; r < 16; ++r) { st.O0[r] = 0.f; st.O1[r] = 0.f; }
        for (int i = 0; i < nct; ++i) {
            const int kt = nct - 1 - i;
            LAS unsigned char* slot = NSA_SLOT(sp);
            __syncthreads();
            if (i + 1 < nct) stage<false>(NSA_SLOT(sp + 1), kc + (size_t)(kt - 1) * 4096, vcd, 64, wid, lane);
            else stage<true>(NSA_SLOT(sp + 1), kc, vcd, 64, wid, lane);
            const int Dk = tlast - 31 - 1024 * kt;
            if (i < 2 || block<2, true>(slot, qf, qsl, pk2((float)(Dk & ~127)), pk2((float)(Dk & 127)), kl, hz, true, false, false, 0, 0, st, imp, tok, 16 * kt, lane))
                block<2>(slot, qf, qsl, pk2((float)(Dk & ~127)), pk2((float)(Dk & 127)), kl, hz, true, __any(64 * kt + 63 > cmax), false, 0, cmax - 64 * kt, st, imp, tok, 16 * kt, lane);
            ++sp;
        }
        float ltot = st.l + xhalf(st.l, lane);
        if (nct > 0) {
            st.nmw = ltot > 0.f ? split2(-(st.m + __builtin_amdgcn_logf(ltot))) : 0x0000c6eau;
            for (int kt = 0; kt < nct; ++kt) {
                LAS unsigned char* slot = NSA_SLOT(sp);
                __syncthreads();
                if (kt + 1 < nct) stage<true>(NSA_SLOT(sp + 1), kc + (size_t)(kt + 1) * 4096, vcd, 64, wid, lane);
                else stage<true>(NSA_SLOT(sp + 1), ks + (size_t)cur * 64 * KVW, 512, KVW, wid, lane);
                const int Dk = tlast - 31 - 1024 * kt;
                block<3>(slot, qf, qsl, pk2((float)(Dk & ~127)), pk2((float)(Dk & 127)), kl, hz, true, __any(64 * kt + 63 > cmax), false, 0, cmax - 64 * kt, st, imp, tok, 16 * kt, lane);
                ++sp;
            }
        }
        { const float sc = gt0; out0 = st.O0 * sc; out1 = st.O1 * sc; }
        __builtin_amdgcn_s_waitcnt(0xc07f); __builtin_amdgcn_wave_barrier();
        unsigned kn = 0u;
        if (tid == 0) kn = __hip_atomic_fetch_add(ctr, 1u, __ATOMIC_RELAXED, __HIP_MEMORY_SCOPE_AGENT);
        {
            const int tk = lane >> 3, u = lane & 7;
            const LAS float* ir = imp + (8 * wid + tk) * IMPS + (u & 1) * IMPP + (u >> 1);
            unsigned mybits = 0u;
            if (u == 0) mybits |= 1u;
            if ((cur & 7) == u) mybits |= 1u << (cur >> 3);
            if (cur >= 1 && ((cur - 1) & 7) == u) mybits |= 1u << ((cur - 1) >> 3);
            const int nforced = cur == 0 ? 1 : (cur == 1 ? 2 : 3);
            const int nsel = (skipm & 8) ? 0 : (cur + 1 < TOPK ? cur + 1 : TOPK) - nforced;
            if (nsel > 0) {
                if (cur < 64) topk_rounds<8>(ir, u, cur, nsel, mybits);
                else if (cur < 128) topk_rounds<16>(ir, u, cur, nsel, mybits);
                else if (cur < 192) topk_rounds<24>(ir, u, cur, nsel, mybits);
                else topk_rounds<32>(ir, u, cur, nsel, mybits);
            }
            selb[(8 * wid + tk) * 8 + u] = mybits;
            unsigned wu = mybits; wu |= __shfl_xor(wu, 8); wu |= __shfl_xor(wu, 16); wu |= __shfl_xor(wu, 32);
            if (lane < 8) wun[wid * 8 + lane] = wu;
        }
        if (tid == 0) *nxtp = nblk + (int)kn;
        __syncthreads();
        if (wid == 0) {
            int base = 0;
            for (int k = 0; k < 4; ++k) { const int b = 64 * k + lane; unsigned w = 0u;
#pragma unroll
                for (int ww = 0; ww < 8; ++ww) w |= wun[ww * 8 + (b & 7)];
                const bool bit = (w >> (b >> 3)) & 1u;
                const unsigned long long bal = __ballot(bit);
                const int pos = base + __popcll(bal & ((1ull << lane) - 1ull));
                if (bit) blist[pos] = b;
                base += __popcll(bal); }
            if (lane == 0) *nbp = base;
        }
        __syncthreads();
        const int nb = (skipm & 2) ? 1 : *nbp;
        const int nitem = __builtin_amdgcn_readfirstlane(*nxtp);
        kl[0] = pk2((float)(63 - key0)); kl[1] = pk2((float)(31 - key0));
        st.m = 0.f; st.l = 0.f; st.nmw = 0u; st.seen = 0; st.carry = 0.f;
#pragma unroll
        for (int r = 0; r < 16; ++r) { st.O0[r] = 0.f; st.O1[r] = 0.f; }
        {
            int b = cur;
            for (int i = 0; i < nb; ++i) {
                LAS unsigned char* slot = NSA_SLOT(sp);
                __syncthreads();
                const int bn = i + 1 < nb ? blist[nb - 2 - i] : 0;
                if (i + 1 < nb) stage<true>(NSA_SLOT(sp + 1), ks + (size_t)bn * 64 * KVW, 512, KVW, wid, lane);
                else stage<true>(NSA_SLOT(sp + 1), kw + (size_t)cur * 64 * KVW, 512, KVW, wid, lane);
                const unsigned wmine = wun[wid * 8 + (b & 7)];
                if ((wmine >> (b >> 3)) & 1u) {
                    const bool member = (selb[tok * 8 + (b & 7)] >> (b >> 3)) & 1u;
                    if (i == 0 || block<0, true>(slot, qf, qsl, pk2((float)(64 * (qt - b))), 0u, kl, hz, member, false, false, 0, 0, st, imp, tok, 0, lane))
                        block<0>(slot, qf, qsl, pk2((float)(64 * (qt - b))), 0u, kl, hz, member, b == cur, false, 0, tl, st, imp, tok, 0, lane);
                }
                b = bn; ++sp;
            }
        }
        ltot = st.l + xhalf(st.l, lane);
        { const float inv = ltot > 0.f ? 1.0f / ltot : 0.f, sc = gt1 * inv; out0 = out0 + st.O0 * sc; out1 = out1 + st.O1 * sc; }
        st.m = 0.f; st.l = 0.f; st.nmw = 0u; st.seen = 0; st.carry = 0.f;
#pragma unroll
        for (int r = 0; r < 16; ++r) { st.O0[r] = 0.f; st.O1[r] = 0.f; }
        {
            const int b0 = cur >= 8 ? cur - 8 : 0, nw = (skipm & 4) ? 1 : cur - b0 + 1;
            for (int i = 0; i < nw; ++i) {
                const int b = cur - i;
                LAS unsigned char* slot = NSA_SLOT(sp);
                __syncthreads();
                if (i + 1 < nw) stage<true>(NSA_SLOT(sp + 1), kw + (size_t)(b - 1) * 64 * KVW, 512, KVW, wid, lane);
                else if (nitem < 1024) NSA_STAGE_ITEM_FIRST(nitem, NSA_SLOT(sp + 1), lane);
                const bool far = (b == cur - 8);
                if (i == 0 || block<0, true>(slot, qf, qsl, pk2((float)(64 * (qt - b))), 0u, kl, hz, true, far, far, far ? tl + 1 : 0, 63, st, imp, tok, 0, lane))
                    block<0>(slot, qf, qsl, pk2((float)(64 * (qt - b))), 0u, kl, hz, true, far || b == cur, far, far ? tl + 1 : 0, far ? 63 : tl, st, imp, tok, 0, lane);
                ++sp;
            }
        }
        ltot = st.l + xhalf(st.l, lane);
        { const float inv = ltot > 0.f ? 1.0f / ltot : 0.f, sc = gt2 * inv; out0 = out0 + st.O0 * sc; out1 = out1 + st.O1 * sc; }
        {
            bf16* op = qout + (size_t)t * D + head * 64 + 4 * hi;
            typedef unsigned u32x2 __attribute__((ext_vector_type(2)));
#pragma unroll
            for (int a = 0; a < 4; ++a) {
                *(u32x2*)(op + 8 * a) = (u32x2){cvtpk(out0[4 * a], out0[4 * a + 1]), cvtpk(out0[4 * a + 2], out0[4 * a + 3])};
                *(u32x2*)(op + 32 + 8 * a) = (u32x2){cvtpk(out1[4 * a], out1[4 * a + 1]), cvtpk(out1[4 * a + 2], out1[4 * a + 3])};
            }
        }
        item = nitem;
    }
#undef NSA_SLOT
#undef NSA_STAGE_ITEM_FIRST
}
}


namespace misc {
DEV float gelu_tanh(float x) { const float u = 0.7978845608028654f * (x + 0.044715f * x * x * x); const float e = __expf(2.0f * u); return 0.5f * x * (1.0f + (1.0f - 2.0f / (e + 1.0f))); }
DEV void prep_rows(const float* __restrict__ xin, bf16* xb, float* ssq, int gw, int ngw, int lane) {
    for (int m = gw; m < T; m += ngw) {
        const float4* xr = (const float4*)(xin + (size_t)m * D) + lane; float ps[4];
#pragma unroll
        for (int j = 0; j < 4; ++j) { const float4 v = xr[64 * j];
            ushort4 o; o.x = f2bf(v.x); o.y = f2bf(v.y); o.z = f2bf(v.z); o.w = f2bf(v.w);
            ((ushort4*)(xb + (size_t)m * D))[lane + 64 * j] = o;
            ps[j] = wave_sum((v.x * v.x + v.y * v.y) + (v.z * v.z + v.w * v.w)); }
        if (lane < 4) *(float4*)(ssq + 16 * (size_t)m + 4 * lane) = make_float4(lane == 0 ? ps[0] : lane == 1 ? ps[1] : lane == 2 ? ps[2] : ps[3], 0.f, 0.f, 0.f);
    }
}
DEV void conv_w(LAS unsigned char* lds, const float* __restrict__ W, const float* __restrict__ sc, bf16* Wt, int K, int N, int Npad, int bid, int nblk, const int tid) {
    LAS float* tile = (LAS float*)lds;
    const int nb = Npad / 64, kb = K / 64;
    for (int it = bid; it < nb * kb; it += nblk) {
        const int k0 = (it / nb) * 64, n0 = (it % nb) * 64;
#pragma unroll
        for (int j = 0; j < 2; ++j) { const int kk = (tid >> 4) + 32 * j, c4 = (tid & 15) * 4, n = n0 + c4;
            float4 v = make_float4(0.f, 0.f, 0.f, 0.f);
            if (n < N) { v = *(const float4*)(W + (size_t)(k0 + kk) * N + n); if (sc) { const float f = sc[k0 + kk]; v.x *= f; v.y *= f; v.z *= f; v.w *= f; } }
            LAS float* tp = tile + kk * 65 + c4; tp[0] = v.x; tp[1] = v.y; tp[2] = v.z; tp[3] = v.w; }
        __syncthreads();
        { const int n = tid >> 3, kc = (tid & 7) * 8; const LAS float* tp = tile + kc * 65 + n;
          u32x4 o; o.x = cvt_pk_bf16(tp[0], tp[65]); o.y = cvt_pk_bf16(tp[2 * 65], tp[3 * 65]); o.z = cvt_pk_bf16(tp[4 * 65], tp[5 * 65]); o.w = cvt_pk_bf16(tp[6 * 65], tp[7 * 65]);
          *(u32x4*)(Wt + (size_t)(n0 + n) * K + k0 + kc) = o; }
        __syncthreads();
    }
}
DEV void cmp_bias_part(const float* __restrict__ pe_k, const float* __restrict__ w1_k, const float* __restrict__ pe_v, const float* __restrict__ w1_v, float* part, int kq, const int tid) {
    const int s = tid >> 8, n = tid & 255; const float* pe = s ? pe_v : pe_k; const float* w1 = s ? w1_v : w1_k; float a = 0.f;
    for (int k = 64 * kq; k < 64 * kq + 64; ++k) a = fmaf(pe[k], w1[(size_t)k * 256 + n], a);
    part[kq * 512 + tid] = a;
}
DEV void cmp_bias_sum(const float* part, float* bias, const int tid) {
    float a = 0.f;
#pragma unroll
    for (int kq = 0; kq < 32; ++kq) a += part[kq * 512 + tid];
    bias[tid] = a;
}
DEV void gates_tile(LAS unsigned char* lds, const bf16* __restrict__ xb, const bf16* __restrict__ wg, const float* ssq, float* gates, int tile, int tid) {
    const int wid = tid >> 6, lane = tid & 63, r16 = lane & 15, kq = lane >> 4;
    const bf16* xp = xb + (size_t)(64 * tile + r16) * D + wid * 128 + 8 * kq;
    const bf16* wp = wg + (size_t)r16 * D + wid * 128 + 8 * kq;
    bf16x8 xf[4][4], wf[3][4];
#pragma unroll
    for (int ks = 0; ks < 4; ++ks) {
#pragma unroll
        for (int tg = 0; tg < 4; ++tg) xf[tg][ks] = *(const bf16x8*)(xp + (size_t)16 * tg * D + 32 * ks);
#pragma unroll
        for (int j = 0; j < 3; ++j) wf[j][ks] = *(const bf16x8*)(wp + (size_t)16 * j * D + 32 * ks);
    }
    f32x4 acc[3][4];
#pragma unroll
    for (int j = 0; j < 3; ++j)
#pragma unroll
        for (int tg = 0; tg < 4; ++tg) { acc[j][tg] = (f32x4){0.f, 0.f, 0.f, 0.f};
#pragma unroll
            for (int ks = 0; ks < 4; ++ks) acc[j][tg] = __builtin_amdgcn_mfma_f32_16x16x32_bf16(wf[j][ks], xf[tg][ks], acc[j][tg], 0, 0, 0); }
    LAS f32x4* red = (LAS f32x4*)lds;
    __syncthreads();
#pragma unroll
    for (int j = 0; j < 3; ++j)
#pragma unroll
        for (int tg = 0; tg < 4; ++tg) red[(wid * 12 + j * 4 + tg) * 64 + lane] = acc[j][tg];
    __syncthreads();
    for (int idx = tid; idx < 768; idx += NTHR) {
        const int j = idx >> 8, tg = (idx >> 6) & 3, ln = idx & 63;
        f32x4 v = red[(j * 4 + tg) * 64 + ln];
#pragma unroll
        for (int w = 1; w < 8; ++w) v = v + red[(w * 12 + j * 4 + tg) * 64 + ln];
        const int t = 64 * tile + 16 * tg + (ln & 15);
        const float ri = rinv16(ssq, t);
        f32x4 g;
#pragma unroll
        for (int e = 0; e < 4; ++e) g[e] = 1.0f / (1.0f + __expf(-v[e] * ri));
        *(f32x4*)(gates + (size_t)t * 48 + 16 * j + 4 * (ln >> 4)) = g;
    }
    __syncthreads();
}
DEV void cmp2(const bf16* __restrict__ hid, const float* __restrict__ w2_k, const float* __restrict__ w2_v, bf16* cmp, int gw, int ngw, int lane) {
    for (int r4 = gw; r4 < 2 * 4096 / 4; r4 += ngw) { const int r = 4 * r4, s = r >> 12; const float* w2 = s ? w2_v : w2_k; const bf16* hr = hid + (size_t)r * 256; float a0 = 0.f, a1 = 0.f, a2 = 0.f, a3 = 0.f;
#pragma unroll 2
        for (int n8 = 0; n8 < 256; n8 += 8) { const uint4 h0 = *(const uint4*)(hr + n8), h1 = *(const uint4*)(hr + 256 + n8), h2 = *(const uint4*)(hr + 512 + n8), h3 = *(const uint4*)(hr + 768 + n8);
            const unsigned w0[4] = {h0.x, h0.y, h0.z, h0.w}, w1[4] = {h1.x, h1.y, h1.z, h1.w}, w2r[4] = {h2.x, h2.y, h2.z, h2.w}, w3[4] = {h3.x, h3.y, h3.z, h3.w};
#pragma unroll
            for (int e = 0; e < 4; ++e) { const float wa = w2[(n8 + 2 * e) * 64 + lane], wb = w2[(n8 + 2 * e + 1) * 64 + lane];
                a0 = fmaf(__uint_as_float(w0[e] << 16), wa, a0); a0 = fmaf(__uint_as_float(w0[e] & 0xffff0000u), wb, a0);
                a1 = fmaf(__uint_as_float(w1[e] << 16), wa, a1); a1 = fmaf(__uint_as_float(w1[e] & 0xffff0000u), wb, a1);
                a2 = fmaf(__uint_as_float(w2r[e] << 16), wa, a2); a2 = fmaf(__uint_as_float(w2r[e] & 0xffff0000u), wb, a2);
                a3 = fmaf(__uint_as_float(w3[e] << 16), wa, a3); a3 = fmaf(__uint_as_float(w3[e] & 0xffff0000u), wb, a3); } }
        bf16* o = cmp + (size_t)r * 64 + lane; o[0] = f2bf(a0); o[64] = f2bf(a1); o[128] = f2bf(a2); o[192] = f2bf(a3); }
}
DEV void final_norm(float* out, const bf16* __restrict__ xb, const float* __restrict__ w, const float* ssq, int gw, int ngw, int lane) {
    for (int m = gw; m < T; m += ngw) { const float r = rinv16(ssq, m); const uint2* xr = (const uint2*)(xb + (size_t)m * D) + lane; float4* orow = (float4*)(out + (size_t)m * D) + lane;
#pragma unroll
        for (int j = 0; j < 4; ++j) { const uint2 v = xr[64 * j]; const float4 ww = ((const float4*)w)[lane + 64 * j];
            orow[64 * j] = make_float4(__uint_as_float(v.x << 16) * r * ww.x, __uint_as_float(v.x & 0xffff0000u) * r * ww.y, __uint_as_float(v.y << 16) * r * ww.z, __uint_as_float(v.y & 0xffff0000u) * r * ww.w); } }
}
}

struct SchedCmp {
    const bf16* KV; const bf16* W1k; const bf16* W1v; int K; int G, c;
    __device__ void init(const bf16* KV_, const bf16* W1k_, const bf16* W1v_, int G_, int c_) { KV = KV_; W1k = W1k_; W1v = W1v_; K = 2048; G = G_; c = c_; }
    __device__ bool next(int i, pg8::Unit& u) const { const int L = i * G + c; if (L >= 32) return false; u.pm = L & 15; u.pn = L >> 4; return true; }
    __device__ __forceinline__ int nk() const { return 32; }
    __device__ __forceinline__ unsigned a_pitch() const { return 16u * KVW * 2u; }
    __device__ __forceinline__ unsigned a_kstep() const { return KVW * 2u; }
    __device__ __forceinline__ const char* a_ptr(const pg8::Unit& u) const { return (const char*)(KV + (size_t)((u.pm & 3) * 256 * 16) * KVW + u.pn * 256 + (u.pm >> 2) * 64); }
    __device__ __forceinline__ const char* b_ptr(const pg8::Unit& u) const { return (const char*)(u.pn ? W1v : W1k); }
};
struct EpiCmp {
    bf16* hid; const float* bias;
    template <class S_t> DEV void prep(LAS unsigned char*, const S_t&, int) const {}
    DEV void operator()(const f32x4 (&acc)[2][2][4][2], const pg8::Unit& u, int wr, int wc, int fr, int fq) const {
        const int row0 = u.pm * 256 + wr * 64 + fr, col0 = wc * 32 + 8 * fq; const float* bs = bias + u.pn * 256; bf16* O = hid + (size_t)u.pn * 4096 * 256;
#pragma unroll
        for (int bj = 0; bj < 2; ++bj) { const f32x4 b0 = *(const f32x4*)(bs + col0 + bj * 128), b1 = *(const f32x4*)(bs + col0 + bj * 128 + 4);
#pragma unroll
            for (int ai = 0; ai < 2; ++ai)
#pragma unroll
                for (int m = 0; m < 4; ++m) { const int r = row0 + ai * 128 + m * 16; f32x4 v0 = acc[ai][bj][m][0] + b0, v1 = acc[ai][bj][m][1] + b1;
#pragma unroll
                    for (int e = 0; e < 4; ++e) { v0[e] = misc::gelu_tanh(v0[e]); v1[e] = misc::gelu_tanh(v1[e]); }
                    u32x4 w; w.x = cvt_pk_bf16(v0[0], v0[1]); w.y = cvt_pk_bf16(v0[2], v0[3]); w.z = cvt_pk_bf16(v1[0], v1[1]); w.w = cvt_pk_bf16(v1[2], v1[3]);
                    *(u32x4*)(O + (size_t)r * 256 + col0 + bj * 128) = w; } }
    }
};


#define XB_TMO      128
#define XB_XCNT(j)  (256  + 64 * (j))
#define XB_XSUB(j)  (1280 + 64 * (j))
#define XB_XGEN(j)  (2304 + 64 * (j))
#define XB_TOP      3328
#define XB_TOPGEN   3392
#define XCD_BAR_WORDS 3456
#define XB_SPIN_CAP (1u << 20)
DEV unsigned xb_ld(unsigned* p)              { return __hip_atomic_load(p, __ATOMIC_RELAXED, __HIP_MEMORY_SCOPE_AGENT); }
DEV unsigned xb_add(unsigned* p, unsigned v) { return __hip_atomic_fetch_add(p, v, __ATOMIC_RELAXED, __HIP_MEMORY_SCOPE_AGENT); }
DEV unsigned xb_xcc_id() { return (unsigned)__builtin_amdgcn_s_getreg((3 << 11) | 20) & 0xFu; }
#define XB_SPIN(cond, bar) do { unsigned _sp = 0; while (cond) { __builtin_amdgcn_s_sleep(1); \
    if ((++_sp & 255u) == 0u) { if (xb_ld(&(bar)[XB_TMO])) break; if (_sp > XB_SPIN_CAP) { atomicAdd(&(bar)[XB_TMO], 1u); break; } } } } while (0)
struct XcdBarrier { unsigned* bar; unsigned x; volatile LAS unsigned* st; };
DEV XcdBarrier xcd_barrier_post(unsigned* bar, volatile LAS unsigned* st, int tid) {
    XcdBarrier b; b.bar = bar; b.x = xb_xcc_id(); b.st = st;
    if (tid == 0) (void)xb_add(&bar[XB_XCNT(b.x)], 1u);
    return b;
}
DEV void xcd_barrier_complete(unsigned* bar, unsigned x, unsigned& nloc, unsigned& nx) {
    const unsigned G = gridDim.x * gridDim.y * gridDim.z;
    unsigned sum, cnt, mine, sp = 0u;
    for (;;) {
        sum = 0u; cnt = 0u; mine = 0u;
#pragma unroll
        for (unsigned j = 0; j < 16; ++j) { const unsigned c = xb_ld(&bar[XB_XCNT(j)]); sum += c; cnt += (c > 0u) ? 1u : 0u; mine = (j == x) ? c : mine; }
        if (sum == G) break;
        __builtin_amdgcn_s_sleep(1);
        if ((++sp & 255u) == 0u) { if (xb_ld(&bar[XB_TMO])) break; if (sp > XB_SPIN_CAP) { atomicAdd(&bar[XB_TMO], 1u); break; } }
    }
    nloc = mine > 0u ? mine : 1u; nx = cnt > 0u ? cnt : 1u;
}
DEV void xcd_barrier(const XcdBarrier& b, int tid) {
    asm volatile("s_waitcnt vmcnt(0)" ::: "memory");
    __syncthreads();
    if (tid == 0) {
        unsigned* bar = b.bar;
        __builtin_amdgcn_s_waitcnt(0);
        unsigned nloc = b.st[0], nx = b.st[1];
        if (nloc == 0u) { xcd_barrier_complete(bar, b.x, nloc, nx); b.st[0] = nloc; b.st[1] = nx; }
        const unsigned old = xb_add(&bar[XB_XSUB(b.x)], 1u);
        const unsigned gen = old / nloc;
        if (old + 1u == (gen + 1u) * nloc) {
            __builtin_amdgcn_fence(__ATOMIC_RELEASE, "agent");
            asm volatile("s_waitcnt vmcnt(0)" ::: "memory");
            (void)xb_add(&bar[XB_TOP], 1u);
        }
        const unsigned tgt = (gen + 1u) * nx;
        XB_SPIN(xb_ld(&bar[XB_TOP]) < tgt, bar);
        __builtin_amdgcn_fence(__ATOMIC_ACQUIRE, "agent");
        asm volatile("s_waitcnt vmcnt(0)" ::: "memory");
    }
    __syncthreads();
}

struct MArgs { const float* in[21]; float* x; unsigned char* ws; int single, ph_lo, ph_hi, pad; };
namespace cg = cooperative_groups;
__global__ void __launch_bounds__(NTHR, 2) mega(MArgs a) {
    extern __shared__ __attribute__((aligned(16))) unsigned char lds_raw[];
    LAS unsigned char* lds = (LAS unsigned char*)lds_raw;
    unsigned char* ws = a.ws; float* x = a.x;
    bf16* XB = (bf16*)(ws + WS_XB); float* SSQ = (float*)(ws + WS_SSQ);
    bf16* WIN_ = (bf16*)(ws + WS_WIN); bf16* WOUT = (bf16*)(ws + WS_WOUT); bf16* WUP = (bf16*)(ws + WS_WUP); bf16* WDN = (bf16*)(ws + WS_WDN); bf16* WKVb = (bf16*)(ws + WS_WKV);
    bf16* WC1K = (bf16*)(ws + WS_WKV + 3 * MiB); bf16* WC1V = (bf16*)(ws + WS_WKV + 4 * MiB);
    bf16* W1IN = (bf16*)(ws + WS_KV + 16 * MiB); bf16* W1OUT = (bf16*)(ws + WS_KV + 24 * MiB); bf16* W1UP = (bf16*)(ws + WS_KV + 26 * MiB); bf16* W1DN = (bf16*)(ws + WS_KV + 34 * MiB);
    bf16* PROJ = (bf16*)(ws + WS_PROJ); bf16* KV = (bf16*)(ws + WS_KV); float* GATES = (float*)(ws + WS_GATES); bf16* CMP = (bf16*)(ws + WS_CMP);
    bf16* HIDC = (bf16*)(ws + WS_BIG + 64 * MiB);
    float* HST = (float*)(ws + WS_KV); float* HAUX = (float*)(ws + WS_KV + 49 * MiB); float* BSEG = (float*)(ws + WS_MISC); float* CBIAS = (float*)(ws + WS_MISC + 256 * 1024);
    const int G = gridDim.x, c = blockIdx.x, ngw = G * NWAVES;
    const int wave_s = __builtin_amdgcn_readfirstlane((int)threadIdx.x >> 6);
#define TID unsigned m1_ = ~0u; asm volatile("" : "+s"(m1_)); int tid = wave_s * 64 + (int)__builtin_amdgcn_mbcnt_hi(m1_, __builtin_amdgcn_mbcnt_lo(m1_, 0u)); asm volatile("" : "+v"(tid)); const int lane = tid & 63, gw = c * NWAVES + (tid >> 6); (void)lane; (void)gw
    volatile LAS unsigned* MISCW = (volatile LAS unsigned*)(lds + 131072 + 64);
    { const int t0_ = threadIdx.x; if (t0_ < 4) MISCW[t0_] = 0u; }
    __syncthreads();
    XcdBarrier xbar; xbar.bar = (unsigned*)(ws + WS_CTL) + 4096; xbar.x = 0; xbar.st = nullptr;
    if (MK_SINGLE || a.single) xbar = xcd_barrier_post((unsigned*)(ws + WS_CTL) + 4096, MISCW, (int)threadIdx.x);
    if (a.pad == 0x7fffffff) cg::this_grid().sync();
    int ph = 0; (void)ph;
#if MK_SINGLE
#define RUN true
#define SYNC do { TID; xcd_barrier(xbar, tid); if (PROBE & 64) xcd_barrier(xbar, tid); } while (0)
#else
#define RUN (a.ph_lo <= ph && ph < a.ph_hi)
#define SYNC do { if (a.single) { TID; xcd_barrier(xbar, tid); if (PROBE & 64) xcd_barrier(xbar, tid); } ++ph; } while (0)
#endif
#define CONV_MLP(layer) do { misc::conv_w(lds, a.in[18] + (size_t)(layer) * D * FF, a.in[17] + (layer) * D, WUP, D, FF, FF, c, G, tid); \
        misc::conv_w(lds, a.in[19] + (size_t)(layer) * FF * D, nullptr, WDN, FF, D, D, c, G, tid); } while (0)
    if (RUN) { TID;
        misc::prep_rows(a.in[0], XB, SSQ, gw, ngw, lane);
        for (int i = c * NTHR + tid; i < 16 * KVW / 2; i += G * NTHR) ((unsigned*)(KV + (size_t)T * KVW))[i] = 0u;
        if (c >= G - 32) misc::cmp_bias_part(a.in[8], a.in[9], a.in[11], a.in[12], CBIAS + 1024, c - (G - 32), tid);
        misc::conv_w(lds, a.in[7], a.in[6], WKVb, D, KVW, KVW, c, G, tid);
        misc::conv_w(lds, a.in[9], nullptr, WC1K, 2048, 256, 256, c, G, tid);
        misc::conv_w(lds, a.in[12], nullptr, WC1V, 2048, 256, 256, c, G, tid);
    }
    if (RUN) { TID;
        misc::conv_w(lds, a.in[2], a.in[1], WIN_, D, 4096, 4096, c, G, tid);
        misc::conv_w(lds, a.in[4], nullptr, WOUT, D, D, D, c, G, tid);
        misc::conv_w(lds, a.in[18], a.in[17], WUP, D, FF, FF, c, G, tid);
        misc::conv_w(lds, a.in[19], nullptr, WDN, FF, D, D, c, G, tid);
    }
#pragma unroll 1
    for (int l = 0; l < 2; ++l) {
        const bf16* wIN = l ? W1IN : WIN_; const bf16* wOUT = l ? W1OUT : WOUT; const bf16* wUP = l ? W1UP : WUP; const bf16* wDN = l ? W1DN : WDN;
        SYNC;
        if (RUN && l == 0 && (c & 1)) { TID;
            misc::conv_w(lds, a.in[2] + (size_t)D * 4096, a.in[1] + D, W1IN, D, 4096, 4096, c >> 1, G >> 1, tid);
            misc::conv_w(lds, a.in[4] + (size_t)D * D, nullptr, W1OUT, D, D, D, c >> 1, G >> 1, tid);
            misc::conv_w(lds, a.in[18] + (size_t)D * FF, a.in[17] + D, W1UP, D, FF, FF, c >> 1, G >> 1, tid);
            misc::conv_w(lds, a.in[19] + (size_t)FF * D, nullptr, W1DN, FF, D, D, c >> 1, G >> 1, tid); }
        if (RUN) for (int rep = 0; rep < ((PROBE & 2) ? 2 : 1); ++rep) { TID; pg8::Sched S; S.init(XB, D, wIN, T, 4096, D, G, c); EpiRowBf16 E{PROJ, SSQ, 4096, ((PROBE & 256) && rep == 0) ? 2 : 0}; pg8::gemm_phase<EpiRowBf16, pg8::Sched, false>(lds, S, E, tid); }
        SYNC;
        if (RUN) for (int rep = ((PROBE & 128) ? 0 : 1); rep < 2; ++rep) { TID; hg::pass1(lds, PROJ, HST, BSEG, HAUX, a.in[5], l, c, G, tid, rep != 0); __syncthreads(); }
        SYNC;
        if (RUN) { TID; hg::scan(HST, BSEG, c * NTHR + tid); if (l == 0 && c == G - 1) misc::cmp_bias_sum(CBIAS + 1024, CBIAS, tid); }
        SYNC;
        if (RUN) for (int rep = ((PROBE & 32) ? 0 : 1); rep < 2; ++rep) { TID; hg::pass2(lds, PROJ, HST, HAUX, a.in[3] + l * 128, c, G, tid, rep ? PROJ : (bf16*)(ws + WS_KV + 16 * MiB), rep ? 4096 : 1024); __syncthreads(); }
        SYNC;
        if (RUN) for (int rep = ((PROBE & 16) ? 0 : 1); rep < 2; ++rep) { TID; pg8::Sched S; S.init(PROJ, 4096, wOUT, T, D, D, G, c); EpiResidual E{XB, SSQ, rep ? 1.0f : 0.0f, 0}; pg8::gemm_phase(lds, S, E, tid); }
        SYNC;
        if (RUN) for (int rep = 0; rep < ((PROBE & 2) ? 2 : 1); ++rep) { TID; pg8::Sched S; S.init(XB, D, wUP, T, FF, D, G, c); EpiRowBf16 E{PROJ, SSQ, FF, ((PROBE & 256) && rep == 0) ? 3 : 1}; pg8::gemm_phase<EpiRowBf16, pg8::Sched, false>(lds, S, E, tid); }
        SYNC;
        if (RUN) for (int rep = ((PROBE & 16) ? 0 : 1); rep < 2; ++rep) { TID; pg8::Sched S; S.init(PROJ, FF, wDN, T, D, FF, G, c); EpiResidual E{XB, SSQ, rep ? 1.0f : 0.0f, 0}; pg8::gemm_phase(lds, S, E, tid); }
        if (l == 1) SYNC;
    }
    if (RUN) for (int rep = 0; rep < ((PROBE & 2) ? 2 : 1); ++rep) { TID; pg8::Sched S; S.init(XB, D, WKVb, T, KVW, D, G, c); EpiRowBf16 E{KV, SSQ, KVW, 0}; pg8::gemm_phase<EpiRowBf16, pg8::Sched, false>(lds, S, E, tid);
        if (rep == 0 && c >= 128) {
            misc::conv_w(lds, a.in[15], a.in[14], WIN_, D, BIN, BINP, c - 128, G - 128, tid);
            misc::conv_w(lds, a.in[16], nullptr, WOUT, D, D, D, c - 128, G - 128, tid);
            misc::conv_w(lds, a.in[18] + (size_t)2 * D * FF, a.in[17] + 2 * D, WUP, D, FF, FF, c - 128, G - 128, tid);
            misc::conv_w(lds, a.in[19] + (size_t)2 * FF * D, nullptr, WDN, FF, D, D, c - 128, G - 128, tid); } }
    SYNC;
    if (RUN) { TID;
        if (c < 32) { SchedCmp S; S.init(KV, WC1K, WC1V, G, c); EpiCmp E{HIDC, CBIAS}; pg8::gemm_phase(lds, S, E, tid); }
        else { pg8::Sched S; S.init(XB, D, WIN_, T, D, D, G - 32, c - 32); EpiRowBf16 E{PROJ, SSQ, D, 0}; pg8::gemm_phase<EpiRowBf16, pg8::Sched, false>(lds, S, E, tid);
            for (int tile = c - 32; tile < T / 64; tile += G - 32) misc::gates_tile(lds, XB, WIN_ + (size_t)D * D, SSQ, GATES, tile, tid); } }
    SYNC;
#pragma unroll 1
    for (int b = 0; b < 2; ++b) {
        if (b == 1) {
            if (RUN) { TID;
                misc::conv_w(lds, a.in[15] + (size_t)D * BIN, a.in[14] + D, WIN_, D, BIN, BINP, c, G, tid);
                misc::conv_w(lds, a.in[16] + (size_t)D * D, nullptr, WOUT, D, D, D, c, G, tid);
                misc::conv_w(lds, a.in[18] + (size_t)3 * D * FF, a.in[17] + 3 * D, WUP, D, FF, FF, c, G, tid);
                misc::conv_w(lds, a.in[19] + (size_t)3 * FF * D, nullptr, WDN, FF, D, D, c, G, tid); }
            SYNC;
        }
        if (b == 0) { if (RUN) { TID; misc::cmp2(HIDC, a.in[10], a.in[13], CMP, c * NWAVES + (tid >> 6), G * NWAVES, lane); } }
        else if (RUN) for (int rep = 0; rep < ((PROBE & 2) ? 2 : 1); ++rep) { TID; pg8::Sched S; S.init(XB, D, WIN_, T, D, D, G, c); EpiRowBf16 E{PROJ, SSQ, D, 0}; pg8::gemm_phase<EpiRowBf16, pg8::Sched, false>(lds, S, E, tid);
            if (rep == 0) { for (int tile = c; tile < T / 64; tile += G) misc::gates_tile(lds, XB, WIN_ + (size_t)D * D, SSQ, GATES, tile, tid); } }
        SYNC;
        if (RUN) { TID; if (PROBE & 1) { nsa::phase(lds, PROJ, GATES, KV, CMP, c, G, tid, PROJ + (size_t)T * D, (PROBE >> 12) & 15, (unsigned*)(ws + WS_CTL) + 12288 + 64 * b + 32); __syncthreads(); } nsa::phase(lds, PROJ, GATES, KV, CMP, c, G, tid, PROJ, 0, (unsigned*)(ws + WS_CTL) + 12288 + 64 * b); }
        SYNC;
        if (RUN) for (int rep = ((PROBE & 16) ? 0 : 1); rep < 2; ++rep) { TID; pg8::Sched S; S.init(PROJ, D, WOUT, T, D, D, G, c); EpiResidual E{XB, SSQ, rep ? 1.0f : 0.0f, 0}; pg8::gemm_phase(lds, S, E, tid); }
        SYNC;
        if (RUN) for (int rep = 0; rep < ((PROBE & 2) ? 2 : 1); ++rep) { TID; pg8::Sched S; S.init(XB, D, WUP, T, FF, D, G, c); EpiRowBf16 E{PROJ, SSQ, FF, ((PROBE & 256) && rep == 0) ? 3 : 1}; pg8::gemm_phase<EpiRowBf16, pg8::Sched, false>(lds, S, E, tid); }
        SYNC;
        if (RUN) for (int rep = ((PROBE & 16) ? 0 : 1); rep < 2; ++rep) { TID; pg8::Sched S; S.init(PROJ, FF, WDN, T, D, FF, G, c); EpiResidual E{XB, SSQ, rep ? 1.0f : 0.0f, 0}; pg8::gemm_phase(lds, S, E, tid); }
        SYNC;
    }
    if (RUN) { TID; misc::final_norm(x, XB, a.in[20], SSQ, gw, ngw, lane); }
#undef RUN
#undef SYNC
}
constexpr int N_PHASES = 1 + 2 * 7 + 3 + 2 * 6;

#ifndef PROBE
#define PROBE 0
#endif
#ifndef MK_SINGLE
#define MK_SINGLE 1
#endif
extern "C" void kernel_launch(void* const* d_in, const int* in_sizes, int n_in, void* d_out, int out_size, void* d_ws, size_t ws_size, hipStream_t stream) {
    if (n_in != 21 || out_size != T * D || ws_size < WS_END) { fprintf(stderr, "kernel_launch: unexpected shapes n_in %d out %d ws %zu (need %zu)\n", n_in, out_size, ws_size, (size_t)WS_END); return; }
    static int grid = 0;
    if (grid == 0) {
        int dev = 0, cus = 0, per_cu = 0;
        if (hipGetDevice(&dev) != hipSuccess || hipDeviceGetAttribute(&cus, hipDeviceAttributeMultiprocessorCount, dev) != hipSuccess) { grid = -1; return; }
        if (hipFuncSetAttribute((const void*)mega, hipFuncAttributeMaxDynamicSharedMemorySize, LDS_BYTES) != hipSuccess) { fprintf(stderr, "kernel_launch: hipFuncSetAttribute failed\n"); grid = -1; return; }
        if (hipOccupancyMaxActiveBlocksPerMultiprocessor(&per_cu, (const void*)mega, NTHR, LDS_BYTES) != hipSuccess || per_cu < 1) { fprintf(stderr, "kernel_launch: occupancy query says %d blocks per CU\n", per_cu); per_cu = 1; }
        (void)hipGetLastError();
        grid = cus > 0 ? cus : 256;
    }
    if (grid < 0) return;
    MArgs a{};
    for (int i = 0; i < 21; ++i) a.in[i] = (const float*)d_in[i];
    a.x = (float*)d_out; a.ws = (unsigned char*)d_ws;
#if MK_SINGLE
    if (hipMemsetAsync((char*)d_ws + WS_CTL, 0, 65536, stream) != hipSuccess) { fprintf(stderr, "kernel_launch: memset failed\n"); return; }
    a.single = 1; a.ph_lo = 0; a.ph_hi = 1000;
    void* args[] = {&a};
    hipError_t e = hipLaunchCooperativeKernel((const void*)mega, dim3(grid), dim3(NTHR), args, LDS_BYTES, stream);
    if (e != hipSuccess) fprintf(stderr, "kernel_launch: cooperative launch failed: %s (grid %d)\n", hipGetErrorString(e), grid);
#else
    for (int ph = 0; ph <= 36; ++ph) { a.single = 0; a.ph_lo = ph; a.ph_hi = ph + 1; hipLaunchKernelGGL(mega, dim3(grid), dim3(NTHR), LDS_BYTES, stream, a); }
#endif
}
```

```cpp
#include <hip/hip_runtime.h>
#include <hip/hip_cooperative_groups.h>
#include <cstdio>
#include <cstdint>

typedef unsigned short bf16;
#define PROBE 0
#ifndef MK_SINGLE
#define MK_SINGLE 1
#endif
#define DEV __device__ __forceinline__

constexpr int T = 16384, D = 1024, FF = 4096;
constexpr int HG_H = 8, HG_DK = 128, HG_DV = 128;
constexpr int NH = 16, NG = 4, NJ = 4, DH = 64;
constexpr int NCMP = 1024, NSLC = 256, TOPK = 16, WIN = 512;
constexpr int KVW = 1536;
constexpr int BIN = 1072, BINP = 1280;
constexpr float EPS = 1e-6f;

constexpr size_t MiB = 1u << 20;
constexpr size_t WS_CTL = 0;
constexpr size_t WS_XB = 1 * MiB;
constexpr size_t WS_SSQ = 33 * MiB;
constexpr size_t WS_MISC = 34 * MiB;
constexpr size_t WS_WIN = 36 * MiB, WS_WOUT = 44 * MiB, WS_WUP = 46 * MiB, WS_WDN = 54 * MiB, WS_WKV = 62 * MiB;
constexpr size_t WS_BIG = 67 * MiB;
constexpr size_t WS_PROJ = WS_BIG;
constexpr size_t WS_KV = WS_BIG + 128 * MiB;
constexpr size_t WS_CMP = WS_BIG + 178 * MiB;
constexpr size_t WS_GATES = WS_BIG + 180 * MiB;
constexpr size_t WS_END = WS_BIG + 184 * MiB;

DEV float bf2f(bf16 b) { return __uint_as_float(((unsigned)b) << 16); }
DEV bf16 f2bf(float f) { unsigned u = __float_as_uint(f); u += 0x7fffu + ((u >> 16) & 1u); return (bf16)(u >> 16); }
DEV float wave_sum(float v) {
#pragma unroll
    for (int o = 1; o < 64; o <<= 1) v += __shfl_xor(v, o);
    return v;
}
DEV float wave_max(float v) {
#pragma unroll
    for (int o = 1; o < 64; o <<= 1) v = fmaxf(v, __shfl_xor(v, o));
    return v;
}
DEV float rinv_of(const float* ssq, int m) { const float4* p = (const float4*)(ssq + 16 * (size_t)m); const float4 a = p[0], b = p[1], c = p[2], d = p[3];
    const float s = (((a.x + a.y) + (a.z + a.w)) + ((b.x + b.y) + (b.z + b.w))) + (((c.x + c.y) + (c.z + c.w)) + ((d.x + d.y) + (d.z + d.w)));
    return rsqrtf(s * (1.0f / D) + EPS); }

#define LAS __attribute__((address_space(3)))
typedef short bf16x8 __attribute__((ext_vector_type(8)));
typedef float f32x4 __attribute__((ext_vector_type(4)));
typedef unsigned u32x4 __attribute__((ext_vector_type(4)));
constexpr int NWAVES = 8, NTHR = 512;
extern __shared__ __attribute__((aligned(16))) unsigned char dyn_lds_base[];
constexpr int RINV_OFF = 131072 + 4096;
constexpr int LDS_BYTES = 147456;
DEV unsigned cvt_pk_bf16(float lo, float hi) { unsigned r; asm volatile("v_cvt_pk_bf16_f32 %0, %1, %2" : "=v"(r) : "v"(lo), "v"(hi)); return r; }
DEV float xlane32(float x, int lane) { const auto r = __builtin_amdgcn_permlane32_swap(__builtin_bit_cast(unsigned, x), __builtin_bit_cast(unsigned, x), false, false); return __builtin_bit_cast(float, (lane & 32) ? r[0] : r[1]); }
DEV float xlane16(float x, int lane) { const auto r = __builtin_amdgcn_permlane16_swap(__builtin_bit_cast(unsigned, x), __builtin_bit_cast(unsigned, x), false, false); return __builtin_bit_cast(float, (lane & 16) ? r[0] : r[1]); }
DEV float swapadd16(float a, float b) { asm volatile("s_nop 1\n\tv_permlane16_swap_b32 %0, %1" : "+v"(a), "+v"(b)); return a + b; }
DEV float swapadd32(float a, float b) { asm volatile("s_nop 1\n\tv_permlane32_swap_b32 %0, %1" : "+v"(a), "+v"(b)); return a + b; }
DEV float rinv16(const float* ssq, int m) { const float4* p = (const float4*)(ssq + 16 * (size_t)m); const float4 a = p[0], b = p[1], c = p[2], d = p[3];
    const float s = (((a.x + a.y) + (a.z + a.w)) + ((b.x + b.y) + (b.z + b.w))) + (((c.x + c.y) + (c.z + c.w)) + ((d.x + d.y) + (d.z + d.w)));
    return rsqrtf(s * (1.0f / D) + EPS); }

namespace pg8 {
constexpr int BM = 256, BK = 64, HALF = 128, HTB = HALF * BK * 2, STAGE_BYTES = 8 * HTB, NXCD = 8, WGM = 8;
__host__ __device__ __forceinline__ int lds_byte(int r, int c) { const int st = (r >> 4) * 2 + (c >> 5), rr = r & 15, cc = c & 31, ob = rr * 64 + cc * 2; return st * 1024 + (ob ^ (((ob >> 9) & 1) << 5)); }
__host__ __device__ __forceinline__ void stage_rc(int b, int& R, int& C) { const int st = b / 1024, sb = b % 1024, swz = sb ^ (((sb >> 9) & 1) << 5); R = (st >> 1) * 16 + swz / 64; C = (st & 1) * 32 + (swz % 64) / 2; }
__host__ __device__ __forceinline__ int perm32(int rho) { const int n = rho >> 4, i = rho & 15; return 8 * (i >> 2) + 4 * n + (i & 3); }
struct Unit { int pm, pn, ui; };
struct Sched {
    const bf16* A; const bf16* Bt; int lda, K; int nM, nN, nwg, G, c;
    __device__ void init(const bf16* A_, int lda_, const bf16* Bt_, int M, int N, int K_, int G_, int c_) { A = A_; Bt = Bt_; lda = lda_; K = K_; nM = M / BM; nN = N / BM; nwg = nM * nN; G = G_; c = c_; }
    __device__ bool next(int i, Unit& u) const {
        const long L = (long)i * G + c; if (L >= nwg) return false;
        int wgid = (int)L; { const int q = nwg / NXCD, r = nwg % NXCD, xcd = wgid % NXCD, off = wgid / NXCD; wgid = (xcd < r ? xcd * (q + 1) : r * (q + 1) + (xcd - r) * q) + off; }
        const int nig = WGM * nN, gid = wgid / nig, fm = gid * WGM, gsz = (nM - fm) < WGM ? (nM - fm) : WGM;
        u.pm = fm + ((wgid % nig) % gsz); u.pn = (wgid % nig) / gsz; return true;
    }
    __device__ __forceinline__ int nk() const { return K / BK; }
    __device__ __forceinline__ unsigned a_pitch() const { return (unsigned)lda * 2u; }
    __device__ __forceinline__ unsigned a_kstep() const { return BK * 2u; }
    __device__ __forceinline__ const char* a_ptr(const Unit& u) const { return (const char*)A + (size_t)u.pm * BM * lda * 2; }
    __device__ __forceinline__ const char* b_ptr(const Unit& u) const { return (const char*)Bt + (size_t)u.pn * BM * K * 2; }
};

template <class Epi, class S_t, bool ALIGN_EPI = true>
__device__ __forceinline__ void gemm_phase(LAS unsigned char* lds, const S_t& S, const Epi& E, const int tid) {
    const int wid = __builtin_amdgcn_readfirstlane(tid >> 6), lane = tid & 63, wr = wid >> 2, wc = wid & 3, fr = lane & 15, fq = lane >> 4;
    const int K = S.K, nt = S.nk();
    const unsigned apitch = S.a_pitch();
    unsigned voffA[2], voffB[2];
#pragma unroll
    for (int i = 0; i < 2; ++i) { int R, C; stage_rc(tid * 16 + i * 8192, R, C); const int Rb = (R & ~31) + perm32(R & 31);
        voffA[i] = (unsigned)R * apitch + (unsigned)C * 2u; voffB[i] = (unsigned)(Rb * K + C) * 2u; }
    const size_t kstepA = S.a_kstep(), kstepB = (size_t)(BK * 2);
    const size_t hstepA = (size_t)HALF * apitch, hstepB = (size_t)HALF * K * 2;
    const unsigned ldsw = (unsigned)wid * 1024u;
    const int aoff = lds_byte(wr * 64 + fr, fq * 8), boff = lds_byte(wc * 32 + fr, fq * 8);
#define PG8_SA(b, h) (((b) * 2 + (h)) * HTB)
#define PG8_SB(b, h) ((4 + (b) * 2 + (h)) * HTB)
#define PG8_STAGE(bufoff, gbase, voff) do { _Pragma("unroll") for (int _i = 0; _i < 2; ++_i) \
        __builtin_amdgcn_global_load_lds((const unsigned*)((const char*)(gbase) + (voff)[_i]), (LAS unsigned*)(lds + (bufoff) + ldsw + _i * 8192), 16, 0, 0); } while (0)
#define PG8_LDA(dst, b, h) do { _Pragma("unroll") for (int m = 0; m < 4; ++m) _Pragma("unroll") for (int k = 0; k < 2; ++k) dst[m][k] = *(const LAS bf16x8*)(lds + PG8_SA(b, h) + aoff + m * 2048 + k * 1024); } while (0)
#define PG8_LDB(dst, b, h) do { _Pragma("unroll") for (int n = 0; n < 2; ++n) _Pragma("unroll") for (int k = 0; k < 2; ++k) dst[n][k] = *(const LAS bf16x8*)(lds + PG8_SB(b, h) + boff + n * 2048 + k * 1024); } while (0)
#define PG8_MMA(ai, bj, At, Bt) do { __builtin_amdgcn_s_setprio(1); _Pragma("unroll") for (int m = 0; m < 4; ++m) _Pragma("unroll") for (int n = 0; n < 2; ++n) { _Pragma("unroll") for (int k = 0; k < 2; ++k) \
        acc[ai][bj][m][n] = __builtin_amdgcn_mfma_f32_16x16x32_bf16(Bt[n][k], At[m][k], acc[ai][bj][m][n], 0, 0, 0); \
        if (m * 2 + n < 7) asm volatile("" : "+v"(Bt[(n + 1) & 1][0]) : "v"(acc[ai][bj][m][n])); } __builtin_amdgcn_s_setprio(0); } while (0)
#define PG8_WAIT_V(n) asm volatile("s_waitcnt vmcnt(" #n ")" ::: "memory")
#define PG8_WAIT_L(n) asm volatile("s_waitcnt lgkmcnt(" #n ")" ::: "memory")
#define PG8_BAR __builtin_amdgcn_s_barrier()
#define PG8_SCHED __builtin_amdgcn_sched_barrier(0)
    Unit cur, nxt; int ui = 0;
    if (!S.next(0, cur)) return;
    cur.ui = 0;
    f32x4 acc[2][2][4][2];
#pragma unroll
    for (int a = 0; a < 2; ++a)
#pragma unroll
        for (int b = 0; b < 2; ++b)
#pragma unroll
            for (int m = 0; m < 4; ++m)
#pragma unroll
                for (int n = 0; n < 2; ++n) acc[a][b][m][n] = (f32x4){0.f, 0.f, 0.f, 0.f};
    bf16x8 At[4][2], B0[2][2], B1[2][2];
    const char* cA = S.a_ptr(cur); const char* cB = S.b_ptr(cur);
    PG8_STAGE(PG8_SB(0, 0), cB, voffB); PG8_STAGE(PG8_SB(0, 1), cB + hstepB, voffB); PG8_STAGE(PG8_SA(0, 0), cA, voffA); PG8_STAGE(PG8_SA(0, 1), cA + hstepA, voffA);
    E.prep(lds, S, tid);
    if (wr == 1) PG8_BAR;
    PG8_WAIT_V(2); PG8_BAR;
    PG8_STAGE(PG8_SB(1, 0), cB + kstepB, voffB); PG8_STAGE(PG8_SA(1, 0), cA + kstepA, voffA); PG8_STAGE(PG8_SB(1, 1), cB + hstepB + kstepB, voffB);
    PG8_WAIT_V(6); PG8_BAR;
    for (;;) {
        const bool has_next = S.next(ui + 1, nxt); nxt.ui = ui + 1;
        const char* nA = has_next ? S.a_ptr(nxt) : cA; const char* nB = has_next ? S.b_ptr(nxt) : cB;
        for (int t = 0; t < nt; t += 2) {
            const bool last = (t == nt - 2);
            const char* a1 = cA + (size_t)(t + 1) * kstepA;
            const char* a2 = last ? nA : cA + (size_t)(t + 2) * kstepA; const char* b2 = last ? nB : cB + (size_t)(t + 2) * kstepB;
            const char* a3 = a2 + kstepA; const char* b3 = b2 + kstepB;
            PG8_LDB(B0, 0, 0); PG8_LDB(B1, 0, 1); PG8_SCHED; PG8_LDA(At, 0, 0); PG8_STAGE(PG8_SA(1, 1), a1 + hstepA, voffA);
            PG8_WAIT_V(8); PG8_WAIT_L(0); PG8_BAR; PG8_MMA(0, 0, At, B0); PG8_MMA(0, 1, At, B1); PG8_BAR; PG8_SCHED;
            PG8_LDA(At, 0, 1); PG8_STAGE(PG8_SB(0, 0), b2, voffB); PG8_STAGE(PG8_SB(0, 1), b2 + hstepB, voffB); PG8_STAGE(PG8_SA(0, 0), a2, voffA);
            PG8_WAIT_V(8); PG8_WAIT_L(0); PG8_BAR; PG8_MMA(1, 0, At, B0); PG8_MMA(1, 1, At, B1); PG8_BAR; PG8_SCHED;
            PG8_LDB(B0, 1, 0); PG8_LDB(B1, 1, 1); PG8_SCHED; PG8_LDA(At, 1, 0); PG8_STAGE(PG8_SA(0, 1), a2 + hstepA, voffA);
            PG8_WAIT_V(8); PG8_WAIT_L(0); PG8_BAR; PG8_MMA(0, 0, At, B0); PG8_MMA(0, 1, At, B1); PG8_BAR; PG8_SCHED;
            PG8_LDA(At, 1, 1); PG8_STAGE(PG8_SB(1, 0), b3, voffB); PG8_STAGE(PG8_SB(1, 1), b3 + hstepB, voffB); PG8_STAGE(PG8_SA(1, 0), a3, voffA);
            PG8_WAIT_V(8); PG8_WAIT_L(0); PG8_BAR; PG8_MMA(1, 0, At, B0); PG8_MMA(1, 1, At, B1); PG8_BAR; PG8_SCHED;
        }
        if constexpr (ALIGN_EPI) { if (wr == 0) PG8_BAR; }
        E(acc, cur, wr, wc, fr, fq);
        if (!has_next) break;
#pragma unroll
        for (int a = 0; a < 2; ++a)
#pragma unroll
            for (int b = 0; b < 2; ++b)
#pragma unroll
                for (int m = 0; m < 4; ++m)
#pragma unroll
                    for (int n = 0; n < 2; ++n) acc[a][b][m][n] = (f32x4){0.f, 0.f, 0.f, 0.f};
        cur = nxt; cA = nA; cB = nB; ++ui;
        if constexpr (ALIGN_EPI) { if (wr == 1) PG8_BAR; }
    }
    PG8_WAIT_V(0);
    if constexpr (!ALIGN_EPI) { if (wr == 0) PG8_BAR; }
    PG8_BAR;
#undef PG8_SA
#undef PG8_SB
#undef PG8_STAGE
#undef PG8_LDA
#undef PG8_LDB
#undef PG8_MMA
#undef PG8_WAIT_V
#undef PG8_WAIT_L
#undef PG8_BAR
#undef PG8_SCHED
}
}

DEV void st16_wt(void* p, u32x4 v) { asm volatile("global_store_dwordx4 %0, %1, off sc1\n\ts_nop 1" :: "v"(p), "v"(v) : "memory"); }
DEV void rinv8(const float* ssq, int row0, int fr, int fq, float (&ri)[8]) {
    const float a = rinv16(ssq, row0 + 128 * (fq >> 1) + 16 * (2 * (fq & 1))), b = rinv16(ssq, row0 + 128 * (fq >> 1) + 16 * (2 * (fq & 1) + 1));
#pragma unroll
    for (int k = 0; k < 8; ++k) ri[k] = __shfl((k & 1) ? b : a, fr + 16 * (k >> 1));
}
struct EpiRowBf16 {
    bf16* O; const float* ssq; int ldc; int act;
    template <class S_t> DEV void prep(LAS unsigned char* lds, const S_t& S, int tid) const {
        LAS float* tab = (LAS float*)(lds + RINV_OFF);
        for (int i = tid; i < 4 * 256; i += NTHR) { pg8::Unit u; if (S.next(i >> 8, u)) tab[i] = rinv16(ssq, u.pm * 256 + (i & 255)); }
        __syncthreads();
    }
    DEV void operator()(const f32x4 (&acc)[2][2][4][2], const pg8::Unit& u, int wr, int wc, int fr, int fq) const {
        const int row0 = u.pm * 256 + wr * 64 + fr, col0 = u.pn * 256 + wc * 32 + 8 * fq;
        float ri8[8];
        if (u.ui < 4) { const LAS float* tab = (const LAS float*)((LAS unsigned char*)dyn_lds_base + RINV_OFF) + u.ui * 256 + wr * 64 + fr;
#pragma unroll
            for (int k = 0; k < 8; ++k) ri8[k] = tab[128 * (k >> 2) + 16 * (k & 3)];
        } else rinv8(ssq, row0, fr, fq, ri8);
#pragma unroll
        for (int ai = 0; ai < 2; ++ai)
#pragma unroll
            for (int m = 0; m < 4; ++m) { const int r = row0 + ai * 128 + m * 16; const float ri = ri8[4 * ai + m]; bf16* rowp = O + (size_t)r * ldc + col0;
#pragma unroll
                for (int bj = 0; bj < 2; ++bj) { f32x4 v0 = acc[ai][bj][m][0] * ri, v1 = acc[ai][bj][m][1] * ri;
                    if (act & 1) {
#pragma unroll
                        for (int e = 0; e < 4; ++e) { const float a = fmaxf(v0[e], 0.f), b = fmaxf(v1[e], 0.f); v0[e] = a * a; v1[e] = b * b; } }
                    u32x4 w; w.x = cvt_pk_bf16(v0[0], v0[1]); w.y = cvt_pk_bf16(v0[2], v0[3]); w.z = cvt_pk_bf16(v1[0], v1[1]); w.w = cvt_pk_bf16(v1[2], v1[3]);
                    if (act & 2) asm volatile("" :: "v"(w)); else st16_wt(rowp + bj * 128, w); } }
    }
};
struct EpiAProj {
    bf16* O; const float* ssq; const float* lbp; int layer;
    template <class S_t> DEV void prep(LAS unsigned char*, const S_t&, int) const {}
    DEV void operator()(const f32x4 (&acc)[2][2][4][2], const pg8::Unit& u, int wr, int wc, int fr, int fq) const {
        const int row0 = u.pm * 256 + wr * 64 + fr, col0 = u.pn * 256 + wc * 32 + 8 * fq;
        if (u.pn >= 4 && u.pn < 8) {
#pragma unroll
            for (int bj = 0; bj < 2; ++bj) {
                float lb[8];
#pragma unroll
                for (int e = 0; e < 8; ++e) { lb[e] = 0.f; if (layer == 1) { const int ch = col0 - 1024 + bj * 128 + e; lb[e] = 1.0f / (1.0f + __expf(lbp[ch] - lbp[1024 + ch])); } }
#pragma unroll
                for (int ai = 0; ai < 2; ++ai)
#pragma unroll
                    for (int m = 0; m < 4; ++m) { const int r = row0 + ai * 128 + m * 16; const float ri = rinv16(ssq, r);
                        float v[8];
#pragma unroll
                        for (int e = 0; e < 4; ++e) { v[e] = acc[ai][bj][m][0][e] * ri; v[4 + e] = acc[ai][bj][m][1][e] * ri; }
#pragma unroll
                        for (int e = 0; e < 8; ++e) { const float xx = fminf(fmaxf(v[e], -30.f), 30.f); const float sg = __builtin_amdgcn_rcpf(1.0f + __builtin_amdgcn_exp2f(-1.4426950408889634f * xx));
                            v[e] = __builtin_amdgcn_logf(fmaxf(lb[e] + (1.0f - lb[e]) * sg, 1e-30f)); }
                        u32x4 w; w.x = cvt_pk_bf16(v[0], v[1]); w.y = cvt_pk_bf16(v[2], v[3]); w.z = cvt_pk_bf16(v[4], v[5]); w.w = cvt_pk_bf16(v[6], v[7]);
                        *(u32x4*)(O + (size_t)r * 4096 + col0 + bj * 128) = w; }
            }
        } else {
#pragma unroll
            for (int ai = 0; ai < 2; ++ai)
#pragma unroll
                for (int m = 0; m < 4; ++m) { const int r = row0 + ai * 128 + m * 16; const float ri = rinv16(ssq, r); bf16* rowp = O + (size_t)r * 4096 + col0;
#pragma unroll
                    for (int bj = 0; bj < 2; ++bj) { const f32x4 v0 = acc[ai][bj][m][0] * ri, v1 = acc[ai][bj][m][1] * ri;
                        u32x4 w; w.x = cvt_pk_bf16(v0[0], v0[1]); w.y = cvt_pk_bf16(v0[2], v0[3]); w.z = cvt_pk_bf16(v1[0], v1[1]); w.w = cvt_pk_bf16(v1[2], v1[3]);
                        *(u32x4*)(rowp + bj * 128) = w; } }
        }
    }
};
struct EpiResidual {
    bf16* xb; float* ssq; float sc; int pad;
    template <class S_t> DEV void prep(LAS unsigned char*, const S_t&, int) const {}
    DEV void operator()(const f32x4 (&acc)[2][2][4][2], const pg8::Unit& u, int wr, int wc, int fr, int fq) const {
        const int row0 = u.pm * 256 + wr * 64 + fr, col0 = u.pn * 256 + wc * 32 + 8 * fq;
#pragma unroll
        for (int ai = 0; ai < 2; ++ai)
#pragma unroll
            for (int m = 0; m < 4; ++m) { const int r = row0 + ai * 128 + m * 16; float part = 0.f;
#pragma unroll
                for (int bj = 0; bj < 2; ++bj) { bf16* p = xb + (size_t)r * D + col0 + bj * 128; const u32x4 o = *(const u32x4*)p;
                    f32x4 v0 = acc[ai][bj][m][0] * sc, v1 = acc[ai][bj][m][1] * sc;
                    v0[0] += __uint_as_float(o.x << 16); v0[1] += __uint_as_float(o.x & 0xffff0000u); v0[2] += __uint_as_float(o.y << 16); v0[3] += __uint_as_float(o.y & 0xffff0000u);
                    v1[0] += __uint_as_float(o.z << 16); v1[1] += __uint_as_float(o.z & 0xffff0000u); v1[2] += __uint_as_float(o.w << 16); v1[3] += __uint_as_float(o.w & 0xffff0000u);
                    u32x4 w; w.x = cvt_pk_bf16(v0[0], v0[1]); w.y = cvt_pk_bf16(v0[2], v0[3]); w.z = cvt_pk_bf16(v1[0], v1[1]); w.w = cvt_pk_bf16(v1[2], v1[3]);
                    *(u32x4*)p = w;
                    part += ((v0[0] * v0[0] + v0[1] * v0[1]) + (v0[2] * v0[2] + v0[3] * v0[3])) + ((v1[0] * v1[0] + v1[1] * v1[1]) + (v1[2] * v1[2] + v1[3] * v1[3])); }
                part += xlane16(part, fr + 16 * fq); part += xlane32(part, fr + 16 * fq);
                if (fq == 0) ssq[(size_t)r * 16 + u.pn * 4 + wc] = part; }
    }
};
struct EpiQG {
    bf16* Q; float* gates; const float* ssq;
    template <class S_t> DEV void prep(LAS unsigned char*, const S_t&, int) const {}
    DEV void operator()(const f32x4 (&acc)[2][2][4][2], const pg8::Unit& u, int wr, int wc, int fr, int fq) const {
        const int row0 = u.pm * 256 + wr * 64 + fr, cl = wc * 32 + 8 * fq;
        float ri8[8]; rinv8(ssq, row0, fr, fq, ri8);
        if (u.pn < 4) {
#pragma unroll
            for (int ai = 0; ai < 2; ++ai)
#pragma unroll
                for (int m = 0; m < 4; ++m) { const int r = row0 + ai * 128 + m * 16; const float ri = ri8[4 * ai + m];
#pragma unroll
                    for (int bj = 0; bj < 2; ++bj) { const f32x4 v0 = acc[ai][bj][m][0] * ri, v1 = acc[ai][bj][m][1] * ri;
                        u32x4 w; w.x = cvt_pk_bf16(v0[0], v0[1]); w.y = cvt_pk_bf16(v0[2], v0[3]); w.z = cvt_pk_bf16(v1[0], v1[1]); w.w = cvt_pk_bf16(v1[2], v1[3]);
                        *(u32x4*)(Q + (size_t)r * D + u.pn * 256 + cl + bj * 128) = w; } }
        } else if (cl < 48) {
#pragma unroll
            for (int ai = 0; ai < 2; ++ai)
#pragma unroll
                for (int m = 0; m < 4; ++m) { const int r = row0 + ai * 128 + m * 16; const float ri = ri8[4 * ai + m];
                    const f32x4 v0 = acc[ai][0][m][0] * ri, v1 = acc[ai][0][m][1] * ri; f32x4 g0, g1;
#pragma unroll
                    for (int e = 0; e < 4; ++e) { g0[e] = 1.0f / (1.0f + __expf(-v0[e])); g1[e] = 1.0f / (1.0f + __expf(-v1[e])); }
                    float* gp = gates + (size_t)r * 48 + cl; *(f32x4*)gp = g0; *(f32x4*)(gp + 4) = g1; }
        }
    }
};


namespace hg {
typedef short s16x4 __attribute__((ext_vector_type(4)));
typedef float f32x2_t __attribute__((ext_vector_type(2))); typedef __bf16 bf16x2_t __attribute__((ext_vector_type(2)));
constexpr int SEGCH = 8, NSEG = T / (64 * SEGCH);
constexpr int L_QT = 0, L_KT = 16384, L_V = 32768, L_ATT = 49152, L_EB = 57344, L_CR = 57856, L_CT = 58368, L_RED = 58880;
DEV unsigned cvtpk(float lo, float hi) { f32x2_t v = {lo, hi}; bf16x2_t b = __builtin_convertvector(v, bf16x2_t); return __builtin_bit_cast(unsigned, b); }
DEV int toff(int row, int col) { return row * 256 + ((((col >> 3) ^ row) & 15) << 4) + (col & 7) * 2; }
DEV int aoff(int t, int s) { return t * 128 + ((((s >> 2) ^ t) & 15) << 3); }
DEV s16x4 trr(LAS unsigned char* p) { return __builtin_bit_cast(s16x4, __builtin_amdgcn_ds_read_tr16_b64_v4i16((LAS s16x4*)p)); }
DEV bf16x8 cat(s16x4 a, s16x4 b) { return __builtin_shufflevector(a, b, 0, 1, 2, 3, 4, 5, 6, 7); }
DEV f32x4 mfma16(bf16x8 a, bf16x8 b, f32x4 c) { return __builtin_amdgcn_mfma_f32_16x16x32_bf16(a, b, c, 0, 0, 0); }
DEV f32x4 mfma16z(bf16x8 a, bf16x8 b) { return __builtin_amdgcn_mfma_f32_16x16x32_bf16(a, b, (f32x4){0.f, 0.f, 0.f, 0.f}, 0, 0, 0); }
template <int CTRL, int RM> DEV float dppadd(float x) { return x + __builtin_bit_cast(float, __builtin_amdgcn_update_dpp(0, __builtin_bit_cast(int, x), CTRL, RM, 0xf, false)); }
DEV float wscan(float x) {
    x = dppadd<0x111, 0xf>(x); x = dppadd<0x112, 0xf>(x); x = dppadd<0x114, 0xf>(x); x = dppadd<0x118, 0xf>(x);
    x = dppadd<0x142, 0xa>(x); x = dppadd<0x143, 0xc>(x); return x;
}
#define WSCAN16_STEP(CTRL) asm volatile("s_nop 1\n\t" \
    "v_add_f32_dpp %0, %0, %0 " CTRL "\n\tv_add_f32_dpp %1, %1, %1 " CTRL "\n\tv_add_f32_dpp %2, %2, %2 " CTRL "\n\tv_add_f32_dpp %3, %3, %3 " CTRL "\n\t" \
    "v_add_f32_dpp %4, %4, %4 " CTRL "\n\tv_add_f32_dpp %5, %5, %5 " CTRL "\n\tv_add_f32_dpp %6, %6, %6 " CTRL "\n\tv_add_f32_dpp %7, %7, %7 " CTRL "\n\t" \
    "v_add_f32_dpp %8, %8, %8 " CTRL "\n\tv_add_f32_dpp %9, %9, %9 " CTRL "\n\tv_add_f32_dpp %10, %10, %10 " CTRL "\n\tv_add_f32_dpp %11, %11, %11 " CTRL "\n\t" \
    "v_add_f32_dpp %12, %12, %12 " CTRL "\n\tv_add_f32_dpp %13, %13, %13 " CTRL "\n\tv_add_f32_dpp %14, %14, %14 " CTRL "\n\tv_add_f32_dpp %15, %15, %15 " CTRL \
    : "+v"(x[0]), "+v"(x[1]), "+v"(x[2]), "+v"(x[3]), "+v"(x[4]), "+v"(x[5]), "+v"(x[6]), "+v"(x[7]), "+v"(x[8]), "+v"(x[9]), "+v"(x[10]), "+v"(x[11]), "+v"(x[12]), "+v"(x[13]), "+v"(x[14]), "+v"(x[15]))
DEV void wscan16(float (&x)[16]) {
    WSCAN16_STEP("row_shr:1 row_mask:0xf bank_mask:0xf"); WSCAN16_STEP("row_shr:2 row_mask:0xf bank_mask:0xf"); WSCAN16_STEP("row_shr:4 row_mask:0xf bank_mask:0xf"); WSCAN16_STEP("row_shr:8 row_mask:0xf bank_mask:0xf");
    WSCAN16_STEP("row_bcast:15 row_mask:0xa bank_mask:0xf"); WSCAN16_STEP("row_bcast:31 row_mask:0xc bank_mask:0xf");
}
DEV float clo(float x, float lo) { return __builtin_amdgcn_fmed3f(x, lo, 3.0e38f); }
DEV float chi(float x, float hi) { return __builtin_amdgcn_fmed3f(x, -3.0e38f, hi); }
DEV float lo16(unsigned w) { return __uint_as_float(w << 16); }
DEV float hi16(unsigned w) { return __uint_as_float(w & 0xffff0000u); }

DEV void scan(float* hst, const float* bseg, int t0, int nthr) {
    for (int t = t0; t < 131072; t += nthr) {
        const int gid = t >> 2, comp = t & 3, lane = gid & 63, tile = (gid >> 6) & 7, hw = gid >> 9, h = hw >> 3, g = lane >> 4;
        const float* bp = bseg + h * 128 + 16 * tile + 4 * g + comp;
        float* hp = hst + t;
        float L[NSEG], B[NSEG];
#pragma unroll
        for (int j = 0; j < NSEG - 1; ++j) { L[j] = __builtin_nontemporal_load(hp + (size_t)j * 131072); B[j] = bp[(size_t)j * 1024]; }
        float run = 0.f;
#pragma unroll
        for (int j = 0; j < NSEG; ++j) {
            hp[(size_t)j * 131072] = run;
            if (j < NSEG - 1) run = fmaf(run, __builtin_amdgcn_exp2f(B[j]), L[j]);
        }
    }
}

constexpr int H_SET = 49152, H_Q = 0, H_K = 16384, H_V = 32768, H_ATT = 98304, H_VEC = 106496  , H_RED = 109568;
DEV void tile_in(LAS unsigned char* tile, const bf16* src, int wid, int lane) {
#pragma unroll
    for (int j = 0; j < 2; ++j) { const int row = 8 * wid + 4 * j + (lane >> 4), ch = (lane ^ row) & 15;
        __builtin_amdgcn_global_load_lds((const unsigned*)(src + (size_t)row * 4096 + ch * 8), (LAS unsigned*)(tile + (8 * wid + 4 * j) * 256), 16, 0, 0); }
}
DEV void tile_out(LAS unsigned char* tile, bf16* dst, int wid, int lane) {
#pragma unroll
    for (int j = 0; j < 2; ++j) { const int row = 8 * wid + 4 * j + (lane >> 4), ch = (lane ^ row) & 15;
        *(u32x4*)(dst + (size_t)row * 4096 + ch * 8) = *(const LAS u32x4*)(tile + (8 * wid + 4 * j) * 256 + lane * 16); }
}
#define HG_BAR() do { asm volatile("s_waitcnt lgkmcnt(0)" ::: "memory"); __builtin_amdgcn_s_barrier(); asm volatile("" ::: "memory"); } while (0)

DEV void pass1(LAS unsigned char* lds, bf16* proj, float* hst, float* bseg, float* aux, const float* __restrict__ lbp, int layer, int bid, int nblk, const int tid, const bool do_store) {
    const int wid = __builtin_amdgcn_readfirstlane(tid >> 6), lane0 = tid & 63;
    for (int item = bid; item < 8 * NSEG; item += nblk) {
        const int h = item & 7, seg = item >> 3;
        float lbv[16];
#pragma unroll
        for (int cc = 0; cc < 16; ++cc) { lbv[cc] = 0.f; if (layer == 1) { const int ch = h * 128 + 16 * wid + cc; lbv[cc] = 1.0f / (1.0f + __expf(lbp[ch] - lbp[1024 + ch])); } }
        f32x4 S[8];
#pragma unroll
        for (int i = 0; i < 8; ++i) S[i] = (f32x4){0.f, 0.f, 0.f, 0.f};
        float segB[16];
#pragma unroll
        for (int cc = 0; cc < 16; ++cc) segB[cc] = 0.f;
        bf16* const pbase = proj + (size_t)(seg * SEGCH * 64) * 4096 + h * 128;
        __syncthreads();
        tile_in(lds + H_Q, pbase, wid, lane0); tile_in(lds + H_K, pbase + 1024, wid, lane0); tile_in(lds + H_V, pbase + 2048, wid, lane0);
        for (int c = 0; c < SEGCH; ++c) {
            const int t0 = (seg * SEGCH + c) * 64;
            int lane = lane0; asm volatile("" : "+v"(lane));
            const int r16 = lane & 15, g = lane >> 4, q4 = r16 >> 2, p4 = r16 & 3;
            LAS unsigned char* const set = lds + (c & 1) * H_SET; LAS unsigned char* const vec = lds + H_VEC + (c & 1) * 1536;
            asm volatile("s_waitcnt vmcnt(0)" ::: "memory");
            HG_BAR();
            if (c + 1 < SEGCH) { LAS unsigned char* nset = lds + ((c + 1) & 1) * H_SET; const bf16* nb = pbase + (size_t)(c + 1) * 64 * 4096;
                tile_in(nset + H_Q, nb, wid, lane); tile_in(nset + H_K, nb + 1024, wid, lane); tile_in(nset + H_V, nb + 2048, wid, lane); }
            {
                float x[16], kk[16], qq[16], ee[16], eb[16];
                const int o0 = lane * 256 + ((((2 * wid) ^ lane) & 15) << 4), o1 = lane * 256 + ((((2 * wid + 1) ^ lane) & 15) << 4);
                const u32x4 f0 = *(const LAS u32x4*)(set + H_K + o0), f1 = *(const LAS u32x4*)(set + H_K + o1), q0 = *(const LAS u32x4*)(set + H_Q + o0), q1 = *(const LAS u32x4*)(set + H_Q + o1);
                const unsigned fw[8] = {f0.x, f0.y, f0.z, f0.w, f1.x, f1.y, f1.z, f1.w};
                const unsigned qw[8] = {q0.x, q0.y, q0.z, q0.w, q1.x, q1.y, q1.z, q1.w};
#pragma unroll
                for (int e = 0; e < 8; ++e) { x[2 * e] = lo16(fw[e]); x[2 * e + 1] = hi16(fw[e]); qq[2 * e] = lo16(qw[e]); qq[2 * e + 1] = hi16(qw[e]); }
#pragma unroll
                for (int cc = 0; cc < 16; ++cc) {
                    const float sg = __builtin_amdgcn_rcpf(1.0f + __builtin_amdgcn_exp2f(-1.4426950408889634f * x[cc]));
                    const float ff = clo(fmaf(1.0f - lbv[cc], sg, lbv[cc]), 1e-30f);
                    kk[cc] = 1.0f - ff;
                    x[cc] = __builtin_amdgcn_logf(ff);
                }
                wscan16(x);
#pragma unroll
                for (int cc = 0; cc < 16; ++cc) {
                    const float refc = clo(__builtin_bit_cast(float, __builtin_amdgcn_readlane(__builtin_bit_cast(int, x[cc]), 31)), -100.f);
                    ee[cc] = __builtin_amdgcn_exp2f(chi(x[cc] - refc, 100.f));
                    kk[cc] *= __builtin_amdgcn_exp2f(chi(refc - x[cc], 100.f)); qq[cc] *= ee[cc];
                    eb[cc] = __builtin_amdgcn_exp2f(x[cc]);
                }
                float* auxp = aux + ((size_t)((seg * SEGCH + c) * 8 + h) * 3) * 128 + 16 * wid;
                if (lane == 63) {
#pragma unroll
                    for (int j = 0; j < 4; ++j) { const f32x4 e4 = {eb[4 * j], eb[4 * j + 1], eb[4 * j + 2], eb[4 * j + 3]}, c4 = {ee[4 * j], ee[4 * j + 1], ee[4 * j + 2], ee[4 * j + 3]};
                        *(LAS f32x4*)(vec + (16 * wid + 4 * j) * 4) = e4; *(LAS f32x4*)(vec + 1024 + (16 * wid + 4 * j) * 4) = c4;
                        *(f32x4*)(auxp + 4 * j) = e4; *(f32x4*)(auxp + 256 + 4 * j) = c4; }
#pragma unroll
                    for (int cc = 0; cc < 16; ++cc) segB[cc] += x[cc];
                }
                if (lane == 31) {
#pragma unroll
                    for (int j = 0; j < 4; ++j) *(f32x4*)(auxp + 128 + 4 * j) = (f32x4){eb[4 * j], eb[4 * j + 1], eb[4 * j + 2], eb[4 * j + 3]};
                }
                unsigned kw[8], qw2[8];
#pragma unroll
                for (int e = 0; e < 8; ++e) { kw[e] = cvtpk(kk[2 * e], kk[2 * e + 1]); qw2[e] = cvtpk(qq[2 * e], qq[2 * e + 1]); }
                *(LAS u32x4*)(set + H_K + o0) = (u32x4){kw[0], kw[1], kw[2], kw[3]}; *(LAS u32x4*)(set + H_K + o1) = (u32x4){kw[4], kw[5], kw[6], kw[7]};
                *(LAS u32x4*)(set + H_Q + o0) = (u32x4){qw2[0], qw2[1], qw2[2], qw2[3]}; *(LAS u32x4*)(set + H_Q + o1) = (u32x4){qw2[4], qw2[5], qw2[6], qw2[7]};
            }
            HG_BAR();
            if (do_store) { bf16* ob = pbase + (size_t)c * 64 * 4096; tile_out(set + H_Q, ob, wid, lane); tile_out(set + H_K, ob + 1024, wid, lane); }
            {
                f32x4 U[8];
#pragma unroll
                for (int ks = 0; ks < 2; ++ks) {
                    const int rowB = 32 * ks + 8 * g + q4, colB = 16 * wid + 4 * p4;
                    const bf16x8 B = cat(trr(set + H_V + toff(rowB, colB)), trr(set + H_V + toff(rowB + 4, colB)));
                    const int ka0 = toff(rowB, 4 * p4), ka1 = toff(rowB + 4, 4 * p4);
#pragma unroll
                    for (int i = 0; i < 8; ++i) {
                        const bf16x8 A = cat(trr(set + H_K + (ka0 ^ (i << 5))), trr(set + H_K + (ka1 ^ (i << 5))));
                        U[i] = ks == 0 ? mfma16z(A, B) : mfma16(A, B, U[i]); }
                }
#pragma unroll
                for (int i = 0; i < 8; ++i) { const f32x4 e = *(const LAS f32x4*)(vec + (16 * i + 4 * g) * 4), ct = *(const LAS f32x4*)(vec + 1024 + (16 * i + 4 * g) * 4); S[i] = S[i] * e + U[i] * ct; }
            }
        }
        float* Ls = hst + ((size_t)((seg * 8 + h) * 8 + wid) * 8) * 256 + lane0 * 4;
#pragma unroll
        for (int i = 0; i < 8; ++i) *(f32x4*)(Ls + i * 256) = S[i];
        if (lane0 == 63) {
#pragma unroll
            for (int cc = 0; cc < 16; ++cc) bseg[(size_t)(seg * 8 + h) * 128 + 16 * wid + cc] = segB[cc];
        }
    }
}

DEV void pass2(LAS unsigned char* lds, bf16* proj, const float* hst, const float* aux, const float* __restrict__ gw, int bid, int nblk, const int tid, bf16* oproj, int old) {
    const int wid = __builtin_amdgcn_readfirstlane(tid >> 6), lane0 = tid & 63;
    for (int item = bid; item < 8 * NSEG; item += nblk) {
        const int h = item & 7, seg = item >> 3;
        f32x4 S[8];
        {
            const float* Ls = hst + ((size_t)((seg * 8 + h) * 8 + wid) * 8) * 256 + lane0 * 4;
#pragma unroll
            for (int i = 0; i < 8; ++i) S[i] = *(const f32x4*)(Ls + i * 256);
        }
        const f32x4 gw4 = *(const f32x4*)(gw + 16 * wid + 4 * (lane0 >> 4));
        const bf16* const pbase = proj + (size_t)(seg * SEGCH * 64) * 4096 + h * 128;
        f32x4 pa = (f32x4){0.f, 0.f, 0.f, 0.f};
        __syncthreads();
        tile_in(lds + H_Q, pbase, wid, lane0); tile_in(lds + H_K, pbase + 1024, wid, lane0); tile_in(lds + H_V, pbase + 2048, wid, lane0);
        if (tid < 96) pa = *(const f32x4*)(aux + ((size_t)((seg * SEGCH) * 8 + h) * 3) * 128 + 4 * tid);
        for (int c = 0; c < SEGCH; ++c) {
            const int t0 = (seg * SEGCH + c) * 64;
            int lane = lane0; asm volatile("" : "+v"(lane));
            const int r16 = lane & 15, g = lane >> 4, q4 = r16 >> 2, p4 = r16 & 3;
            const int TY = (g ^ r16) & 15;
            const int TQ = r16 * 256 + (TY << 4);
            const int TH = r16 * 256 + ((((g >> 1) ^ r16) & 15) << 4) + 8 * (g & 1);
            const int TA = r16 * 128 + (TY << 3);
            LAS unsigned char* const set = lds + (c & 1) * H_SET; LAS unsigned char* const vec = lds + H_VEC + (c & 1) * 1536;
            asm volatile("s_waitcnt vmcnt(0)" ::: "memory");
            if (tid < 96) *(LAS f32x4*)(vec + 16 * tid) = pa;
            HG_BAR();
            if (c + 1 < SEGCH) { LAS unsigned char* nset = lds + ((c + 1) & 1) * H_SET; const bf16* nb = pbase + (size_t)(c + 1) * 64 * 4096;
                tile_in(nset + H_Q, nb, wid, lane); tile_in(nset + H_K, nb + 1024, wid, lane); tile_in(nset + H_V, nb + 2048, wid, lane);
                if (tid < 96) pa = *(const f32x4*)(aux + ((size_t)((seg * SEGCH + c + 1) * 8 + h) * 3) * 128 + 4 * tid); }
            uint2 gv[4];
#pragma unroll
            for (int tt = 0; tt < 4; ++tt) gv[tt] = *(const uint2*)(proj + (size_t)(t0 + 16 * tt + r16) * 4096 + 3072 + h * 128 + 16 * wid + 4 * g);
            f32x4 O[4];
#pragma unroll
            for (int i = 0; i < 2; ++i) {
                const int idx = 2 * wid + i, st = idx >> 2, tt = idx & 3; unsigned w0 = 0u, w1 = 0u;
                if (st <= tt) {
                    f32x4 a;
#pragma unroll
                    for (int ks = 0; ks < 4; ++ks) {
                        const bf16x8 A = *(const LAS bf16x8*)(set + H_K + 4096 * st + (TQ ^ (ks << 6)));
                        const bf16x8 B = *(const LAS bf16x8*)(set + H_Q + 4096 * tt + (TQ ^ (ks << 6)));
                        a = ks == 0 ? mfma16z(A, B) : mfma16(A, B, a);
                    }
                    if (st == tt) {
#pragma unroll
                        for (int e = 0; e < 4; ++e) a[e] = (4 * g + e > r16) ? 0.f : a[e];
                    }
                    w0 = cvtpk(a[0], a[1]); w1 = cvtpk(a[2], a[3]);
                }
                const int t = 16 * tt + r16;
                { typedef unsigned u32x2 __attribute__((ext_vector_type(2))); *(LAS u32x2*)(lds + H_ATT + aoff(t, 16 * st + 4 * g)) = (u32x2){w0, w1}; }
            }
            HG_BAR();
#pragma unroll
            for (int ks = 0; ks < 4; ++ks) {
                const f32x4 c0 = *(const LAS f32x4*)(vec + 512 + (32 * ks + 4 * g) * 4), c1 = *(const LAS f32x4*)(vec + 512 + (32 * ks + 16 + 4 * g) * 4);
                u32x4 sw; sw.x = cvtpk(S[2 * ks][0] * c0[0], S[2 * ks][1] * c0[1]); sw.y = cvtpk(S[2 * ks][2] * c0[2], S[2 * ks][3] * c0[3]);
                sw.z = cvtpk(S[2 * ks + 1][0] * c1[0], S[2 * ks + 1][1] * c1[1]); sw.w = cvtpk(S[2 * ks + 1][2] * c1[2], S[2 * ks + 1][3] * c1[3]);
                const bf16x8 A = __builtin_bit_cast(bf16x8, sw);
#pragma unroll
                for (int tt = 0; tt < 4; ++tt) { const int t = 16 * tt + r16;
                    const s16x4 b0 = *(const volatile LAS s16x4*)(set + H_Q + 4096 * tt + (TH ^ (ks << 6))), b1 = *(const volatile LAS s16x4*)(set + H_Q + 4096 * tt + (TH ^ 32 ^ (ks << 6)));
                    O[tt] = ks == 0 ? mfma16z(A, cat(b0, b1)) : mfma16(A, cat(b0, b1), O[tt]); }
            }
#pragma unroll
            for (int ks = 0; ks < 2; ++ks) {
                const int rowA = 32 * ks + 4 * g + q4, colA = 16 * wid + 4 * p4;
                const bf16x8 A = cat(trr(set + H_V + toff(rowA, colA)), trr(set + H_V + toff(rowA + 16, colA)));
#pragma unroll
                for (int tt = 0; tt < 4; ++tt) if (32 * ks <= 16 * tt + 15) { const int t = 16 * tt + r16;
                    const s16x4 b0 = *(const volatile LAS s16x4*)(lds + H_ATT + 2048 * tt + (TA ^ (ks << 6))), b1 = *(const volatile LAS s16x4*)(lds + H_ATT + 2048 * tt + (TA ^ 32 ^ (ks << 6)));
                    O[tt] = mfma16(A, cat(b0, b1), O[tt]); }
            }
            {
                f32x4 U[8];
#pragma unroll
                for (int ks = 0; ks < 2; ++ks) {
                    const int rowB = 32 * ks + 8 * g + q4, colB = 16 * wid + 4 * p4;
                    const bf16x8 B = cat(trr(set + H_V + toff(rowB, colB)), trr(set + H_V + toff(rowB + 4, colB)));
                    const int ka0 = toff(rowB, 4 * p4), ka1 = toff(rowB + 4, 4 * p4);
#pragma unroll
                    for (int i = 0; i < 8; ++i) {
                        const bf16x8 A = cat(trr(set + H_K + (ka0 ^ (i << 5))), trr(set + H_K + (ka1 ^ (i << 5))));
                        U[i] = ks == 0 ? mfma16z(A, B) : mfma16(A, B, U[i]); }
                }
#pragma unroll
                for (int i = 0; i < 8; ++i) { const f32x4 e = *(const LAS f32x4*)(vec + (16 * i + 4 * g) * 4), ct = *(const LAS f32x4*)(vec + 1024 + (16 * i + 4 * g) * 4); S[i] = S[i] * e + U[i] * ct; }
            }
            LAS float* red = (LAS float*)(lds + H_RED);
            { float p[4];
#pragma unroll
              for (int tt = 0; tt < 4; ++tt) p[tt] = (O[tt][0] * O[tt][0] + O[tt][1] * O[tt][1]) + (O[tt][2] * O[tt][2] + O[tt][3] * O[tt][3]);
              const float tot = swapadd32(swapadd16(p[0], p[1]), swapadd16(p[2], p[3]));
              red[wid * 64 + 4 * r16 + g] = tot; }
            HG_BAR();
            f32x4 ss = *(const LAS f32x4*)(red + 4 * r16);
#pragma unroll
            for (int w = 1; w < 8; ++w) ss = ss + *(const LAS f32x4*)(red + w * 64 + 4 * r16);
#pragma unroll
            for (int tt = 0; tt < 4; ++tt) { const int t = 16 * tt + r16; const float ssum = ss[tt];
                const float ri = rsqrtf(ssum * (1.0f / 128.0f) + EPS);
                const float g0 = lo16(gv[tt].x), g1 = hi16(gv[tt].x), g2 = lo16(gv[tt].y), g3 = hi16(gv[tt].y);
                const float o0 = O[tt][0] * ri * gw4[0] * g0 * __builtin_amdgcn_rcpf(1.0f + __expf(-g0)), o1 = O[tt][1] * ri * gw4[1] * g1 * __builtin_amdgcn_rcpf(1.0f + __expf(-g1));
                const float o2 = O[tt][2] * ri * gw4[2] * g2 * __builtin_amdgcn_rcpf(1.0f + __expf(-g2)), o3 = O[tt][3] * ri * gw4[3] * g3 * __builtin_amdgcn_rcpf(1.0f + __expf(-g3));
                *(uint2*)(oproj + (size_t)(t0 + t) * old + h * 128 + 16 * wid + 4 * g) = make_uint2(cvtpk(o0, o1), cvtpk(o2, o3)); }
        }
    }
}
}

namespace nsa {
typedef float f32x16 __attribute__((ext_vector_type(16)));
typedef short s16x4 __attribute__((ext_vector_type(4)));
typedef float f32x2_t __attribute__((ext_vector_type(2))); typedef __bf16 bf16x2_t __attribute__((ext_vector_type(2)));
constexpr int IMPS = 264, IMPP = 132;
constexpr int L_IMP = 0, L_KV = 67584, L_SELB = 100352, L_WUN = 102400, L_BL = 102656, L_NB = 103744;
constexpr float NINF = -__builtin_inff();
DEV unsigned cvtpk(float lo, float hi) { f32x2_t v = {lo, hi}; bf16x2_t b = __builtin_convertvector(v, bf16x2_t); return __builtin_bit_cast(unsigned, b); }
DEV f32x16 mfma32(bf16x8 a, bf16x8 b, f32x16 c) { return __builtin_amdgcn_mfma_f32_32x32x16_bf16(a, b, c, 0, 0, 0); }
DEV s16x4 trr(LAS unsigned char* p) { return __builtin_bit_cast(s16x4, __builtin_amdgcn_ds_read_tr16_b64_v4i16((LAS s16x4*)p)); }
DEV bf16x8 cat(s16x4 a, s16x4 b) { return __builtin_shufflevector(a, b, 0, 1, 2, 3, 4, 5, 6, 7); }
DEV float ex2(float x) { return __builtin_amdgcn_exp2f(x); }
DEV float xhalf(float x, int lane) {
    const auto r = __builtin_amdgcn_permlane32_swap(__builtin_bit_cast(unsigned, x), __builtin_bit_cast(unsigned, x), false, false);
    return __builtin_bit_cast(float, lane < 32 ? r[1] : r[0]); }

template <bool WV> DEV void stage(LAS unsigned char* slot, const bf16* kbase, long vdelta, int stride, int wid, int lane) {
    const int row = 8 * wid + (lane >> 3), ch = (lane ^ (row >> 1)) & 7;
    const unsigned lo = (unsigned)(row * stride + ch * 8) * 2u;
    const char* kp = (const char*)kbase + lo;
    __builtin_amdgcn_global_load_lds((const unsigned*)kp, (LAS unsigned*)(slot + wid * 1024), 16, 0, 0);
    if (WV) __builtin_amdgcn_global_load_lds((const unsigned*)(kp + vdelta), (LAS unsigned*)(slot + 8192 + wid * 1024), 16, 0, 0);
}

template <int CTRL> DEV float dppf(float x) { return __builtin_bit_cast(float, __builtin_amdgcn_update_dpp(0, __builtin_bit_cast(int, x), CTRL, 0xf, 0xf, true)); }
template <int CTRL> DEV unsigned dppu(unsigned x) { return (unsigned)__builtin_amdgcn_update_dpp(0, (int)x, CTRL, 0xf, 0xf, true); }
struct St { float m, l; unsigned nmw; int seen; f32x16 O0, O1; float carry; };
DEV unsigned split2(float x) { const unsigned w0 = cvtpk(x, 0.f); const float hf = __uint_as_float(w0 << 16); return (w0 & 0xffffu) | (cvtpk(x - hf, 0.f) << 16); }
DEV unsigned pk2(float x) { return cvtpk(x, x); }

template <int MODE, bool FAST = false>
DEV bool block(LAS unsigned char* slot, const bf16x8 (&qf)[4], unsigned qsl, unsigned kd0, unsigned kd1, const unsigned (&kl)[2], unsigned hz, bool member,
               bool need_mask, bool two_sided, int lo, int hi_, St& st, LAS float* imp, int tokrow, int nsbase, int lane) {
    const int key0 = lane & 31, hi = lane >> 5;
    f32x16 s0, s1;
    {
        bf16x8 ka[4][2];
#pragma unroll
        for (int ks = 0; ks < 4; ++ks) { const int off = key0 * 128 + ((((2 * ks + hi) ^ (key0 >> 1)) & 7) << 4);
            ka[ks][0] = *(const LAS bf16x8*)(slot + off); ka[ks][1] = *(const LAS bf16x8*)(slot + 4096 + off); }
        const u32x4 qa = {qsl, qsl, qsl, member ? st.nmw : 0x0000c6eau  };
        const u32x4 k0 = {kd0 & hz, kd1 & hz, kl[0] & hz, 0x3f803f80u & hz}, k1 = {kd0 & hz, kd1 & hz, kl[1] & hz, 0x3f803f80u & hz};
        __builtin_amdgcn_sched_barrier(0);
        f32x16 z;
#pragma unroll
        for (int r = 0; r < 16; ++r) z[r] = 0.f;
        s0 = mfma32(__builtin_bit_cast(bf16x8, k0), __builtin_bit_cast(bf16x8, qa), z);
#pragma unroll
        for (int ks = 0; ks < 4; ++ks) s0 = mfma32(ka[ks][0], qf[ks], s0);
        u32x4 k1o = k1; asm volatile("" : "+v"(k1o) : "v"(s0));
        s1 = mfma32(__builtin_bit_cast(bf16x8, k1o), __builtin_bit_cast(bf16x8, qa), z);
#pragma unroll
        for (int ks = 0; ks < 4; ++ks) s1 = mfma32(ka[ks][1], qf[ks], s1);
    }
    bf16x8 va[2][2][2];
    if (MODE == 0 || MODE == 3) {
        const int i16 = lane & 15, q4 = i16 >> 2, p4 = i16 & 3, dsub = (lane >> 4) & 1;
#pragma unroll
        for (int tau = 0; tau < 2; ++tau)
#pragma unroll
            for (int s = 0; s < 2; ++s) { const int row = 32 * tau + 16 * s + 4 * hi + q4;
#pragma unroll
                for (int dt = 0; dt < 2; ++dt) { const int col = 32 * dt + 16 * dsub + 4 * p4;
                    const int o0 = 8192 + row * 128 + ((((col >> 3) ^ (row >> 1)) & 7) << 4) + ((col >> 2) & 1) * 8;
                    const int o1 = 8192 + (row + 8) * 128 + ((((col >> 3) ^ ((row + 8) >> 1)) & 7) << 4) + ((col >> 2) & 1) * 8;
                    va[tau][s][dt] = cat(trr(slot + o0), trr(slot + o1)); } }
    }
    __builtin_amdgcn_sched_barrier(0);
    if (need_mask) {
        const int lo2 = lo - 4 * hi, hi2 = hi_ - 4 * hi;
        if (!two_sided) {
#pragma unroll
            for (int r = 0; r < 16; ++r) { const int c0 = (r & 3) + 8 * (r >> 2);
                s0[r] = (c0 <= hi2) ? s0[r] : NINF; s1[r] = (c0 + 32 <= hi2) ? s1[r] : NINF; }
        } else {
#pragma unroll
            for (int r = 0; r < 16; ++r) { const int c0 = (r & 3) + 8 * (r >> 2), c1 = c0 + 32;
                s0[r] = (c0 >= lo2 && c0 <= hi2) ? s0[r] : NINF; s1[r] = (c1 >= lo2 && c1 <= hi2) ? s1[r] : NINF; }
        }
    }
    if ((MODE == 0 || MODE == 2) && FAST) {
        float ls = 0.f;
#pragma unroll
        for (int r = 0; r < 16; ++r) { s0[r] = ex2(s0[r]); s1[r] = ex2(s1[r]); ls += s0[r] + s1[r]; }
        if (__any(!(ls < 65536.f) || st.seen == 0)) return true;
        st.l += ls;
    } else if (MODE == 0 || MODE == 2) {
        float m0 = s0[0], m1 = s1[0];
#pragma unroll
        for (int r = 1; r < 16; ++r) { m0 = fmaxf(m0, s0[r]); m1 = fmaxf(m1, s1[r]); }
        float mloc = fmaxf(m0, m1);
        mloc = fmaxf(mloc, xhalf(mloc, lane));
        const bool valid = mloc > -1e4f, fresh = st.seen == 0;
        const float delta = valid ? (fresh ? mloc : fmaxf(mloc, 0.f)) : 0.f;
        float alpha = 1.0f;
        if (__any(delta != 0.f)) {
            alpha = fresh ? 1.0f : ex2(-delta);
#pragma unroll
            for (int r = 0; r < 16; ++r) { s0[r] -= delta; s1[r] -= delta; }
            st.m += delta; st.nmw = split2(-st.m);
            if (MODE == 0) { if (!__all(alpha == 1.0f)) { st.O0 = st.O0 * alpha; st.O1 = st.O1 * alpha; } }
        }
        float ls = 0.f;
#pragma unroll
        for (int r = 0; r < 16; ++r) { s0[r] = ex2(s0[r]); s1[r] = ex2(s1[r]); ls += s0[r] + s1[r]; }
        st.l = st.l * alpha + ls; st.seen |= valid ? 1 : 0;
    } else {
#pragma unroll
        for (int r = 0; r < 16; ++r) { s0[r] = ex2(s0[r]); s1[r] = ex2(s1[r]); }
    }
    if (MODE == 0 || MODE == 3) {
        bf16x8 pb[2][2];
#pragma unroll
        for (int s = 0; s < 2; ++s) {
            u32x4 w0, w1;
            w0.x = cvtpk(s0[8 * s + 0], s0[8 * s + 1]); w0.y = cvtpk(s0[8 * s + 2], s0[8 * s + 3]); w0.z = cvtpk(s0[8 * s + 4], s0[8 * s + 5]); w0.w = cvtpk(s0[8 * s + 6], s0[8 * s + 7]);
            w1.x = cvtpk(s1[8 * s + 0], s1[8 * s + 1]); w1.y = cvtpk(s1[8 * s + 2], s1[8 * s + 3]); w1.z = cvtpk(s1[8 * s + 4], s1[8 * s + 5]); w1.w = cvtpk(s1[8 * s + 6], s1[8 * s + 7]);
            pb[0][s] = __builtin_bit_cast(bf16x8, w0); pb[1][s] = __builtin_bit_cast(bf16x8, w1);
        }
        __builtin_amdgcn_sched_barrier(0);
#pragma unroll
        for (int tau = 0; tau < 2; ++tau)
#pragma unroll
            for (int s = 0; s < 2; ++s) st.O0 = mfma32(va[tau][s][0], pb[tau][s], st.O0);
        asm volatile("" : "+v"(pb[0][0]) : "v"(st.O0));
#pragma unroll
        for (int tau = 0; tau < 2; ++tau)
#pragma unroll
            for (int s = 0; s < 2; ++s) st.O1 = mfma32(va[tau][s][1], pb[tau][s], st.O1);
    }
    if (MODE == 3) {
        float val[8];
        float carry = st.carry;
#pragma unroll
        for (int j = 0; j < 8; ++j) {
            const int tau = j >> 2, a = j & 3;
            const float p0 = tau ? s1[4 * a] : s0[4 * a], p1 = tau ? s1[4 * a + 1] : s0[4 * a + 1], p2 = tau ? s1[4 * a + 2] : s0[4 * a + 2], p3 = tau ? s1[4 * a + 3] : s0[4 * a + 3];
            float Q = (p0 + p1) + (p2 + p3), L = p3;
            Q += dppf<0xB1>(Q); L += dppf<0xB1>(L); Q += dppf<0x4E>(Q); L += dppf<0x4E>(L);
            const float Lx = xhalf(L, lane);
            val[j] = Q + (hi ? Lx : carry);
            carry = Lx;
        }
        st.carry = carry;
        if ((lane & 3) == 0) {
            const unsigned ip = (unsigned)(unsigned long)(imp + tokrow * IMPS + hi * IMPP + (nsbase >> 1));
            typedef float f32x4 __attribute__((ext_vector_type(4)));
            const f32x4 w0 = {val[0], val[1], val[2], val[3]}, w1 = {val[4], val[5], val[6], val[7]};
            asm volatile("ds_write_b128 %0, %1\n\tds_write_b128 %0, %2 offset:16" :: "v"(ip), "v"(w0), "v"(w1) : "memory");
        }
    }
    return false;
}

template <int NI>
DEV void topk_rounds(const LAS float* ir, int u, int cur, int nsel, unsigned& mybits) {
    unsigned sc[NI];
#pragma unroll
    for (int i = 0; i < NI; ++i) { const int ns = u + 8 * i; const float v = ir[4 * i];
        const bool forced = (ns == 0) || (ns == cur) || (ns == cur - 1);
        sc[i] = (ns <= cur && !forced) ? ((__float_as_uint(v) & 0xFFFFFE00u) | (unsigned)(256 - ns)) : 0u; }
    unsigned prev = 0xFFFFFFFFu;
    for (int r = 0; r < nsel; ++r) {
        const unsigned pm1 = prev - 1u;
        unsigned mn = pm1 - sc[0];
#pragma unroll
        for (int i = 1; i < NI; ++i) { const unsigned d = pm1 - sc[i]; mn = mn < d ? mn : d; }
        { unsigned o = dppu<0xB1>(mn); mn = mn < o ? mn : o; o = dppu<0x4E>(mn); mn = mn < o ? mn : o; o = dppu<0x141>(mn); mn = mn < o ? mn : o; }
        const unsigned mx = pm1 - mn; prev = mx;
        const int wns = 256 - (int)(mx & 0x1FFu);
        if ((wns & 7) == u) mybits |= 1u << (wns >> 3);
    }
}

DEV void phase(LAS unsigned char* lds, bf16* qb, const float* __restrict__ gates, const bf16* __restrict__ kv, const bf16* __restrict__ cmp, int bid, int nblk, const int tid0, bf16* qout, const int skipm, unsigned* ctr) {
    const int wid = __builtin_amdgcn_readfirstlane(tid0 >> 6);
    LAS float* imp = (LAS float*)(lds + L_IMP);
    LAS unsigned* selb = (LAS unsigned*)(lds + L_SELB);
    LAS unsigned* wun = (LAS unsigned*)(lds + L_WUN);
    LAS int* blist = (LAS int*)(lds + L_BL);
    LAS int* nbp = (LAS int*)(lds + L_NB);
    const long vcd = (long)NG * NCMP * 64 * 2;
#define NSA_SLOT(p) (lds + L_KV + ((p) & 1) * 16384)
#define NSA_STAGE_ITEM_FIRST(ITEM, SLOTP, LANE) do { const int g_ = (ITEM) & 3, qt_ = 255 - ((ITEM) >> 2); const int tl_ = 64 * qt_ + 63; const int nct_ = (skipm & 1) ? 0 : (tl_ >= 31 ? (((tl_ - 31) >> 4) >> 6) + 1 : 0); \
        if (nct_ > 0) stage<true>(SLOTP, cmp + (size_t)g_ * NCMP * 64 + (size_t)(nct_ - 1) * 4096, vcd, 64, wid, LANE); \
        else stage<true>(SLOTP, kv + 2 * 256 + g_ * 64 + (size_t)qt_ * 64 * KVW, 512, KVW, wid, LANE); } while (0)
    int sp = 0;
    if (bid < 1024) NSA_STAGE_ITEM_FIRST(bid, NSA_SLOT(0), (tid0 & 63));
    LAS int* nxtp = (LAS int*)(lds + L_NB + 4);
    int item = bid;
    while (item < 1024) {
        int tid = tid0; asm volatile("" : "+v"(tid));
        const int lane = tid & 63, n = lane & 31, hi = lane >> 5;
        const int g = item & 3, qt = 255 - (item >> 2), cur = qt;
        const int tok = 8 * wid + (n >> 2), t = 64 * qt + tok, tl = tok, head = 4 * g + (n & 3);
        const float sl2 = ex2(-0.5f * (float)(head + 1)) * 1.4426950408889634f;
        bf16x8 qf[4];
        {
            const bf16* qp = qb + (size_t)t * D + head * 64 + 8 * hi;
#pragma unroll
            for (int ks = 0; ks < 4; ++ks) { const u32x4 w = *(const u32x4*)(qp + 16 * ks); const float sc = 0.125f * 1.4426950408889634f; u32x4 o;
                o.x = cvtpk(__uint_as_float(w.x << 16) * sc, __uint_as_float(w.x & 0xffff0000u) * sc); o.y = cvtpk(__uint_as_float(w.y << 16) * sc, __uint_as_float(w.y & 0xffff0000u) * sc);
                o.z = cvtpk(__uint_as_float(w.z << 16) * sc, __uint_as_float(w.z & 0xffff0000u) * sc); o.w = cvtpk(__uint_as_float(w.w << 16) * sc, __uint_as_float(w.w & 0xffff0000u) * sc);
                qf[ks] = __builtin_bit_cast(bf16x8, o); }
        }
        const float* gp = gates + (size_t)t * 48 + head * 3;
        const float gt0 = gp[0], gt1 = gp[1], gt2 = gp[2];
        f32x16 out0, out1;
#pragma unroll
        for (int r = 0; r < 16; ++r) { out0[r] = 0.f; out1[r] = 0.f; }
        St st;
        const unsigned hz = hi ? 0u : 0xffffffffu, qsl = split2(-sl2);
        const int key0 = lane & 31;
        unsigned kl[2];
        __syncthreads();
        const int tlast = 64 * qt + 63;
        const int nct = (skipm & 1) ? 0 : (tlast >= 31 ? (((tlast - 31) >> 4) >> 6) + 1 : 0);
        const bf16* kc = cmp + (size_t)g * NCMP * 64; const bf16* ks = kv + 2 * 256 + g * 64; const bf16* kw = kv + 4 * 256 + g * 64;
        const int cmax = (t - 31) >> 4;
        kl[0] = pk2(-16.f * (float)key0); kl[1] = pk2(-16.f * (float)(key0 + 32));
        st.m = 0.f; st.l = 0.f; st.nmw = 0u; st.seen = 0; st.carry = 0.f;
#pragma unroll
        for (int r = 0; r < 16; ++r) { st.O0[r] = 0.f; st.O1[r] = 0.f; }
        for (int i = 0; i < nct; ++i) {
            const int kt = nct - 1 - i;
            LAS unsigned char* slot = NSA_SLOT(sp);
            __syncthreads();
            if (i + 1 < nct) stage<false>(NSA_SLOT(sp + 1), kc + (size_t)(kt - 1) * 4096, vcd, 64, wid, lane);
            else stage<true>(NSA_SLOT(sp + 1), kc, vcd, 64, wid, lane);
            const int Dk = tlast - 31 - 1024 * kt;
            if (i < 2 || block<2, true>(slot, qf, qsl, pk2((float)(Dk & ~127)), pk2((float)(Dk & 127)), kl, hz, true, false, false, 0, 0, st, imp, tok, 16 * kt, lane))
                block<2>(slot, qf, qsl, pk2((float)(Dk & ~127)), pk2((float)(Dk & 127)), kl, hz, true, __any(64 * kt + 63 > cmax), false, 0, cmax - 64 * kt, st, imp, tok, 16 * kt, lane);
            ++sp;
        }
        float ltot = st.l + xhalf(st.l, lane);
        if (nct > 0) {
            st.nmw = ltot > 0.f ? split2(-(st.m + __builtin_amdgcn_logf(ltot))) : 0x0000c6eau;
            for (int kt = 0; kt < nct; ++kt) {
                LAS unsigned char* slot = NSA_SLOT(sp);
                __syncthreads();
                if (kt + 1 < nct) stage<true>(NSA_SLOT(sp + 1), kc + (size_t)(kt + 1) * 4096, vcd, 64, wid, lane);
                else stage<true>(NSA_SLOT(sp + 1), ks + (size_t)cur * 64 * KVW, 512, KVW, wid, lane);
                const int Dk = tlast - 31 - 1024 * kt;
                block<3>(slot, qf, qsl, pk2((float)(Dk & ~127)), pk2((float)(Dk & 127)), kl, hz, true, __any(64 * kt + 63 > cmax), false, 0, cmax - 64 * kt, st, imp, tok, 16 * kt, lane);
                ++sp;
            }
        }
        { const float sc = gt0; out0 = st.O0 * sc; out1 = st.O1 * sc; }
        __builtin_amdgcn_s_waitcnt(0xc07f); __builtin_amdgcn_wave_barrier();
        unsigned kn = 0u;
        if (tid == 0) kn = __hip_atomic_fetch_add(ctr, 1u, __ATOMIC_RELAXED, __HIP_MEMORY_SCOPE_AGENT);
        {
            const int tk = lane >> 3, u = lane & 7;
            const LAS float* ir = imp + (8 * wid + tk) * IMPS + (u & 1) * IMPP + (u >> 1);
            unsigned mybits = 0u;
            if (u == 0) mybits |= 1u;
            if ((cur & 7) == u) mybits |= 1u << (cur >> 3);
            if (cur >= 1 && ((cur - 1) & 7) == u) mybits |= 1u << ((cur - 1) >> 3);
            const int nforced = cur == 0 ? 1 : (cur == 1 ? 2 : 3);
            const int nsel = (skipm & 8) ? 0 : (cur + 1 < TOPK ? cur + 1 : TOPK) - nforced;
            if (nsel > 0) {
                if (cur < 64) topk_rounds<8>(ir, u, cur, nsel, mybits);
                else if (cur < 128) topk_rounds<16>(ir, u, cur, nsel, mybits);
                else if (cur < 192) topk_rounds<24>(ir, u, cur, nsel, mybits);
                else topk_rounds<32>(ir, u, cur, nsel, mybits);
            }
            selb[(8 * wid + tk) * 8 + u] = mybits;
            unsigned wu = mybits; wu |= __shfl_xor(wu, 8); wu |= __shfl_xor(wu, 16); wu |= __shfl_xor(wu, 32);
            if (lane < 8) wun[wid * 8 + lane] = wu;
        }
        if (tid == 0) *nxtp = nblk + (int)kn;
        __syncthreads();
        if (wid == 0) {
            int base = 0;
            for (int k = 0; k < 4; ++k) { const int b = 64 * k + lane; unsigned w = 0u;
#pragma unroll
                for (int ww = 0; ww < 8; ++ww) w |= wun[ww * 8 + (b & 7)];
                const bool bit = (w >> (b >> 3)) & 1u;
                const unsigned long long bal = __ballot(bit);
                const int pos = base + __popcll(bal & ((1ull << lane) - 1ull));
                if (bit) blist[pos] = b;
                base += __popcll(bal); }
            if (lane == 0) *nbp = base;
        }
        __syncthreads();
        const int nb = (skipm & 2) ? 1 : *nbp;
        const int nitem = __builtin_amdgcn_readfirstlane(*nxtp);
        kl[0] = pk2((float)(63 - key0)); kl[1] = pk2((float)(31 - key0));
        st.m = 0.f; st.l = 0.f; st.nmw = 0u; st.seen = 0; st.carry = 0.f;
#pragma unroll
        for (int r = 0; r < 16; ++r) { st.O0[r] = 0.f; st.O1[r] = 0.f; }
        {
            int b = cur;
            for (int i = 0; i < nb; ++i) {
                LAS unsigned char* slot = NSA_SLOT(sp);
                __syncthreads();
                const int bn = i + 1 < nb ? blist[nb - 2 - i] : 0;
                if (i + 1 < nb) stage<true>(NSA_SLOT(sp + 1), ks + (size_t)bn * 64 * KVW, 512, KVW, wid, lane);
                else stage<true>(NSA_SLOT(sp + 1), kw + (size_t)cur * 64 * KVW, 512, KVW, wid, lane);
                const unsigned wmine = wun[wid * 8 + (b & 7)];
                if ((wmine >> (b >> 3)) & 1u) {
                    const bool member = (selb[tok * 8 + (b & 7)] >> (b >> 3)) & 1u;
                    if (i == 0 || block<0, true>(slot, qf, qsl, pk2((float)(64 * (qt - b))), 0u, kl, hz, member, false, false, 0, 0, st, imp, tok, 0, lane))
                        block<0>(slot, qf, qsl, pk2((float)(64 * (qt - b))), 0u, kl, hz, member, b == cur, false, 0, tl, st, imp, tok, 0, lane);
                }
                b = bn; ++sp;
            }
        }
        ltot = st.l + xhalf(st.l, lane);
        { const float inv = ltot > 0.f ? 1.0f / ltot : 0.f, sc = gt1 * inv; out0 = out0 + st.O0 * sc; out1 = out1 + st.O1 * sc; }
        st.m = 0.f; st.l = 0.f; st.nmw = 0u; st.seen = 0; st.carry = 0.f;
#pragma unroll
        for (int r = 0; r < 16; ++r) { st.O0[r] = 0.f; st.O1[r] = 0.f; }
        {
            const int b0 = cur >= 8 ? cur - 8 : 0, nw = (skipm & 4) ? 1 : cur - b0 + 1;
            for (int i = 0; i < nw; ++i) {
                const int b = cur - i;
                LAS unsigned char* slot = NSA_SLOT(sp);
                __syncthreads();
                if (i + 1 < nw) stage<true>(NSA_SLOT(sp + 1), kw + (size_t)(b - 1) * 64 * KVW, 512, KVW, wid, lane);
                else if (nitem < 1024) NSA_STAGE_ITEM_FIRST(nitem, NSA_SLOT(sp + 1), lane);
                const bool far = (b == cur - 8);
                if (i == 0 || block<0, true>(slot, qf, qsl, pk2((float)(64 * (qt - b))), 0u, kl, hz, true, far, far, far ? tl + 1 : 0, 63, st, imp, tok, 0, lane))
                    block<0>(slot, qf, qsl, pk2((float)(64 * (qt - b))), 0u, kl, hz, true, far || b == cur, far, far ? tl + 1 : 0, far ? 63 : tl, st, imp, tok, 0, lane);
                ++sp;
            }
        }
        ltot = st.l + xhalf(st.l, lane);
        { const float inv = ltot > 0.f ? 1.0f / ltot : 0.f, sc = gt2 * inv; out0 = out0 + st.O0 * sc; out1 = out1 + st.O1 * sc; }
        {
            bf16* op = qout + (size_t)t * D + head * 64 + 4 * hi;
            typedef unsigned u32x2 __attribute__((ext_vector_type(2)));
#pragma unroll
            for (int a = 0; a < 4; ++a) {
                *(u32x2*)(op + 8 * a) = (u32x2){cvtpk(out0[4 * a], out0[4 * a + 1]), cvtpk(out0[4 * a + 2], out0[4 * a + 3])};
                *(u32x2*)(op + 32 + 8 * a) = (u32x2){cvtpk(out1[4 * a], out1[4 * a + 1]), cvtpk(out1[4 * a + 2], out1[4 * a + 3])};
            }
        }
        item = nitem;
    }
#undef NSA_SLOT
#undef NSA_STAGE_ITEM_FIRST
}
}


namespace misc {
DEV float gelu_tanh(float x) { const float u = 0.7978845608028654f * (x + 0.044715f * x * x * x); const float e = __expf(2.0f * u); return 0.5f * x * (1.0f + (1.0f - 2.0f / (e + 1.0f))); }
DEV void prep_rows(const float* __restrict__ xin, bf16* xb, float* ssq, int gw, int ngw, int lane) {
    typedef unsigned u32x2 __attribute__((ext_vector_type(2)));
    for (int m0 = gw; m0 < T; m0 += 4 * ngw) {
        float4 v[4][4];
#pragma unroll
        for (int k = 0; k < 4; ++k) { const int m = m0 + k * ngw; const float4* xr = (const float4*)(xin + (size_t)(m < T ? m : gw) * D) + lane;
#pragma unroll
            for (int j = 0; j < 4; ++j) { const f32x4 q = __builtin_nontemporal_load((const f32x4*)(xr + 64 * j)); v[k][j] = make_float4(q[0], q[1], q[2], q[3]); } }
        float ps[16];
#pragma unroll
        for (int k = 0; k < 4; ++k) { const int m = m0 + k * ngw;
#pragma unroll
            for (int j = 0; j < 4; ++j) { const float4 q = v[k][j];
                if (m < T) ((u32x2*)(xb + (size_t)m * D))[lane + 64 * j] = (u32x2){cvt_pk_bf16(q.x, q.y), cvt_pk_bf16(q.z, q.w)};
                ps[4 * k + j] = (q.x * q.x + q.y * q.y) + (q.z * q.z + q.w * q.w); } }
        hg::wscan16(ps);
#pragma unroll
        for (int k = 0; k < 4; ++k) { const int m = m0 + k * ngw;
            float t[4];
#pragma unroll
            for (int j = 0; j < 4; ++j) t[j] = __builtin_bit_cast(float, __builtin_amdgcn_readlane(__builtin_bit_cast(int, ps[4 * k + j]), 63));
            if (m < T && lane < 4) *(float4*)(ssq + 16 * (size_t)m + 4 * lane) = make_float4(lane == 0 ? t[0] : lane == 1 ? t[1] : lane == 2 ? t[2] : t[3], 0.f, 0.f, 0.f); }
    }
}
DEV void conv_w(LAS unsigned char* lds, const float* __restrict__ W, const float* __restrict__ sc, bf16* Wt, int K, int N, int Npad, int bid, int nblk, const int tid) {
    constexpr int CONV_NT = 4;
    const int nb = Npad / 64, kb = K / 64, nt = nb * kb;
    for (int it = bid; it < nt; it += CONV_NT * nblk) {
        float4 v[CONV_NT][2];
#pragma unroll
        for (int u = 0; u < CONV_NT; ++u) { const int iu = it + u * nblk; const bool on = iu < nt; const int k0 = (iu / nb) * 64, n0 = (iu % nb) * 64;
#pragma unroll
            for (int j = 0; j < 2; ++j) { const int kk = (tid >> 4) + 32 * j, n = n0 + (tid & 15) * 4;
                v[u][j] = make_float4(0.f, 0.f, 0.f, 0.f);
                if (on && n < N) { const f32x4 q = __builtin_nontemporal_load((const f32x4*)(W + (size_t)(k0 + kk) * N + n)); v[u][j] = make_float4(q[0], q[1], q[2], q[3]); } } }
#pragma unroll
        for (int u = 0; u < CONV_NT; ++u) { const int iu = it + u * nblk; const int k0 = iu < nt ? (iu / nb) * 64 : 0; LAS float* tile = (LAS float*)lds + u * 4224;
#pragma unroll
            for (int j = 0; j < 2; ++j) { const int kk = (tid >> 4) + 32 * j, c4 = (tid & 15) * 4; float4 w = v[u][j];
                if (sc) { const float f = sc[k0 + kk]; w.x *= f; w.y *= f; w.z *= f; w.w *= f; }
                LAS float* tp = tile + kk * 65 + c4; tp[0] = w.x; tp[1] = w.y; tp[2] = w.z; tp[3] = w.w; } }
        __syncthreads();
#pragma unroll
        for (int u = 0; u < CONV_NT; ++u) { const int iu = it + u * nblk; if (iu < nt) { const int k0 = (iu / nb) * 64, n0 = (iu % nb) * 64;
            const int n = tid >> 3, kc = (tid & 7) * 8; const LAS float* tp = (const LAS float*)lds + u * 4224 + kc * 65 + n;
            u32x4 o; o.x = cvt_pk_bf16(tp[0], tp[65]); o.y = cvt_pk_bf16(tp[2 * 65], tp[3 * 65]); o.z = cvt_pk_bf16(tp[4 * 65], tp[5 * 65]); o.w = cvt_pk_bf16(tp[6 * 65], tp[7 * 65]);
            *(u32x4*)(Wt + (size_t)(n0 + n) * K + k0 + kc) = o; } }
        __syncthreads();
    }
}
DEV void cmp_bias_part(const float* __restrict__ pe_k, const float* __restrict__ w1_k, const float* __restrict__ pe_v, const float* __restrict__ w1_v, float* part, int kq, const int tid) {
    const int s = tid >> 8, n = tid & 255; const float* pe = s ? pe_v : pe_k; const float* w1 = s ? w1_v : w1_k; float a = 0.f;
    float wv[64];
#pragma unroll
    for (int i = 0; i < 64; ++i) wv[i] = w1[(size_t)(64 * kq + i) * 256 + n];
#pragma unroll
    for (int i = 0; i < 64; ++i) a = fmaf(pe[64 * kq + i], wv[i], a);
    part[kq * 512 + tid] = a;
}
DEV void cmp_bias_sum(const float* part, float* bias, const int tid) {
    float a = 0.f;
#pragma unroll
    for (int kq = 0; kq < 32; ++kq) a += part[kq * 512 + tid];
    bias[tid] = a;
}
DEV void gates_tile(LAS unsigned char* lds, const bf16* __restrict__ xb, const bf16* __restrict__ wg, const float* ssq, float* gates, int tile, int tid) {
    const int wid = tid >> 6, lane = tid & 63, r16 = lane & 15, kq = lane >> 4;
    const bf16* xp = xb + (size_t)(64 * tile + r16) * D + wid * 128 + 8 * kq;
    const bf16* wp = wg + (size_t)r16 * D + wid * 128 + 8 * kq;
    bf16x8 xf[4][4], wf[3][4];
#pragma unroll
    for (int ks = 0; ks < 4; ++ks) {
#pragma unroll
        for (int tg = 0; tg < 4; ++tg) xf[tg][ks] = *(const bf16x8*)(xp + (size_t)16 * tg * D + 32 * ks);
#pragma unroll
        for (int j = 0; j < 3; ++j) wf[j][ks] = *(const bf16x8*)(wp + (size_t)16 * j * D + 32 * ks);
    }
    f32x4 acc[3][4];
#pragma unroll
    for (int j = 0; j < 3; ++j)
#pragma unroll
        for (int tg = 0; tg < 4; ++tg) { acc[j][tg] = (f32x4){0.f, 0.f, 0.f, 0.f};
#pragma unroll
            for (int ks = 0; ks < 4; ++ks) acc[j][tg] = __builtin_amdgcn_mfma_f32_16x16x32_bf16(wf[j][ks], xf[tg][ks], acc[j][tg], 0, 0, 0); }
    LAS f32x4* red = (LAS f32x4*)lds;
    __syncthreads();
#pragma unroll
    for (int j = 0; j < 3; ++j)
#pragma unroll
        for (int tg = 0; tg < 4; ++tg) red[(wid * 12 + j * 4 + tg) * 64 + lane] = acc[j][tg];
    __syncthreads();
    for (int idx = tid; idx < 768; idx += NTHR) {
        const int j = idx >> 8, tg = (idx >> 6) & 3, ln = idx & 63;
        f32x4 v = red[(j * 4 + tg) * 64 + ln];
#pragma unroll
        for (int w = 1; w < 8; ++w) v = v + red[(w * 12 + j * 4 + tg) * 64 + ln];
        const int t = 64 * tile + 16 * tg + (ln & 15);
        const float ri = rinv16(ssq, t);
        f32x4 g;
#pragma unroll
        for (int e = 0; e < 4; ++e) g[e] = 1.0f / (1.0f + __expf(-v[e] * ri));
        *(f32x4*)(gates + (size_t)t * 48 + 16 * j + 4 * (ln >> 4)) = g;
    }
    __syncthreads();
}
DEV void cmp2(LAS unsigned char* lds, const bf16* __restrict__ hid, const float* __restrict__ w2_k, const float* __restrict__ w2_v, bf16* cmp, int c, int G, const int tid) {
    LAS float* wl = (LAS float*)lds;
    const int wid = tid >> 6, lane = tid & 63;
    int cur_s = -1;
    for (int base = c * NWAVES; base < 2 * 4096 / 4; base += G * NWAVES) {
        const int r = 4 * (base + wid), s = base >> 10;
        uint2 hv[4];
#pragma unroll
        for (int k = 0; k < 4; ++k) hv[k] = *(const uint2*)(hid + (size_t)(r + k) * 256 + 4 * lane);
        if (s != cur_s) { __syncthreads(); const f32x4* src = (const f32x4*)(s ? w2_v : w2_k); f32x4 t[8];
#pragma unroll
            for (int i = 0; i < 8; ++i) t[i] = src[tid + 512 * i];
#pragma unroll
            for (int i = 0; i < 8; ++i) ((LAS f32x4*)wl)[tid + 512 * i] = t[i];
            cur_s = s; __syncthreads(); }
        float acc[4] = {0.f, 0.f, 0.f, 0.f};
#pragma unroll 8
        for (int n4 = 0; n4 < 64; ++n4) {
            const float wa = wl[(4 * n4) * 64 + lane], wb = wl[(4 * n4 + 1) * 64 + lane], wc = wl[(4 * n4 + 2) * 64 + lane], wd = wl[(4 * n4 + 3) * 64 + lane];
#pragma unroll
            for (int k = 0; k < 4; ++k) { const unsigned ux = (unsigned)__builtin_amdgcn_readlane((int)hv[k].x, n4), uy = (unsigned)__builtin_amdgcn_readlane((int)hv[k].y, n4);
                acc[k] = fmaf(__uint_as_float(ux << 16), wa, acc[k]); acc[k] = fmaf(__uint_as_float(ux & 0xffff0000u), wb, acc[k]);
                acc[k] = fmaf(__uint_as_float(uy << 16), wc, acc[k]); acc[k] = fmaf(__uint_as_float(uy & 0xffff0000u), wd, acc[k]); } }
        bf16* o = cmp + (size_t)r * 64 + lane; o[0] = f2bf(acc[0]); o[64] = f2bf(acc[1]); o[128] = f2bf(acc[2]); o[192] = f2bf(acc[3]);
    }
}
DEV void final_norm(float* out, const bf16* __restrict__ xb, const float* __restrict__ w, const float* ssq, int gw, int ngw, int lane) {
    float4 ww[4];
#pragma unroll
    for (int j = 0; j < 4; ++j) ww[j] = ((const float4*)w)[lane + 64 * j];
    for (int m0 = gw; m0 < T; m0 += 4 * ngw) {
        uint2 v[4][4]; float r[4];
#pragma unroll
        for (int k = 0; k < 4; ++k) { const int m = m0 + k * ngw; if (m < T) { const uint2* xr = (const uint2*)(xb + (size_t)m * D) + lane;
#pragma unroll
                for (int j = 0; j < 4; ++j) { typedef unsigned u32x2 __attribute__((ext_vector_type(2))); const u32x2 q = __builtin_nontemporal_load((const u32x2*)(xr + 64 * j)); v[k][j] = make_uint2(q[0], q[1]); }
                r[k] = rinv16(ssq, m); } }
#pragma unroll
        for (int k = 0; k < 4; ++k) { const int m = m0 + k * ngw; if (m < T) { float4* orow = (float4*)(out + (size_t)m * D) + lane;
#pragma unroll
                for (int j = 0; j < 4; ++j) { const f32x4 o = {__uint_as_float(v[k][j].x << 16) * r[k] * ww[j].x, __uint_as_float(v[k][j].x & 0xffff0000u) * r[k] * ww[j].y,
                                                                 __uint_as_float(v[k][j].y << 16) * r[k] * ww[j].z, __uint_as_float(v[k][j].y & 0xffff0000u) * r[k] * ww[j].w};
                    __builtin_nontemporal_store(o, (f32x4*)(orow + 64 * j)); } } }
    }
}
}

struct SchedCmp {
    const bf16* KV; const bf16* W1k; const bf16* W1v; int K; int G, c;
    __device__ void init(const bf16* KV_, const bf16* W1k_, const bf16* W1v_, int G_, int c_) { KV = KV_; W1k = W1k_; W1v = W1v_; K = 2048; G = G_; c = c_; }
    __device__ bool next(int i, pg8::Unit& u) const { const int L = i * G + c; if (L >= 32) return false; u.pm = L & 15; u.pn = L >> 4; return true; }
    __device__ __forceinline__ int nk() const { return 32; }
    __device__ __forceinline__ unsigned a_pitch() const { return 16u * KVW * 2u; }
    __device__ __forceinline__ unsigned a_kstep() const { return KVW * 2u; }
    __device__ __forceinline__ const char* a_ptr(const pg8::Unit& u) const { return (const char*)(KV + (size_t)((u.pm & 3) * 256 * 16) * KVW + u.pn * 256 + (u.pm >> 2) * 64); }
    __device__ __forceinline__ const char* b_ptr(const pg8::Unit& u) const { return (const char*)(u.pn ? W1v : W1k); }
};
struct EpiCmp {
    bf16* hid; const float* bias;
    template <class S_t> DEV void prep(LAS unsigned char*, const S_t&, int) const {}
    DEV void operator()(const f32x4 (&acc)[2][2][4][2], const pg8::Unit& u, int wr, int wc, int fr, int fq) const {
        const int row0 = u.pm * 256 + wr * 64 + fr, col0 = wc * 32 + 8 * fq; const float* bs = bias + u.pn * 256; bf16* O = hid + (size_t)u.pn * 4096 * 256;
#pragma unroll
        for (int bj = 0; bj < 2; ++bj) { const f32x4 b0 = *(const f32x4*)(bs + col0 + bj * 128), b1 = *(const f32x4*)(bs + col0 + bj * 128 + 4);
#pragma unroll
            for (int ai = 0; ai < 2; ++ai)
#pragma unroll
                for (int m = 0; m < 4; ++m) { const int r = row0 + ai * 128 + m * 16; f32x4 v0 = acc[ai][bj][m][0] + b0, v1 = acc[ai][bj][m][1] + b1;
#pragma unroll
                    for (int e = 0; e < 4; ++e) { v0[e] = misc::gelu_tanh(v0[e]); v1[e] = misc::gelu_tanh(v1[e]); }
                    u32x4 w; w.x = cvt_pk_bf16(v0[0], v0[1]); w.y = cvt_pk_bf16(v0[2], v0[3]); w.z = cvt_pk_bf16(v1[0], v1[1]); w.w = cvt_pk_bf16(v1[2], v1[3]);
                    *(u32x4*)(O + (size_t)r * 256 + col0 + bj * 128) = w; } }
    }
};


#define XB_TMO      128
#define XB_XCNT(j)  (256  + 64 * (j))
#define XB_XSUB(j)  (1280 + 64 * (j))
#define XB_XGEN(j)  (2304 + 64 * (j))
#define XB_TOP      3328
#define XB_TOPGEN   3392
#define XCD_BAR_WORDS 3456
#define XB_SPIN_CAP (1u << 20)
DEV unsigned xb_ld(unsigned* p)              { return __hip_atomic_load(p, __ATOMIC_RELAXED, __HIP_MEMORY_SCOPE_AGENT); }
DEV unsigned xb_add(unsigned* p, unsigned v) { return __hip_atomic_fetch_add(p, v, __ATOMIC_RELAXED, __HIP_MEMORY_SCOPE_AGENT); }
DEV unsigned xb_xcc_id() { return (unsigned)__builtin_amdgcn_s_getreg((3 << 11) | 20) & 0xFu; }
#define XB_SPIN(cond, bar) do { unsigned _sp = 0; while (cond) { __builtin_amdgcn_s_sleep(1); \
    if ((++_sp & 255u) == 0u) { if (xb_ld(&(bar)[XB_TMO])) break; if (_sp > XB_SPIN_CAP) { atomicAdd(&(bar)[XB_TMO], 1u); break; } } } } while (0)
struct XcdBarrier { unsigned* bar; unsigned x; volatile LAS unsigned* st; };
DEV XcdBarrier xcd_barrier_post(unsigned* bar, volatile LAS unsigned* st, int tid) {
    XcdBarrier b; b.bar = bar; b.x = xb_xcc_id(); b.st = st;
    if (tid == 0) (void)xb_add(&bar[XB_XCNT(b.x)], 1u);
    return b;
}
DEV void xcd_barrier_complete(unsigned* bar, unsigned x, unsigned& nloc, unsigned& nx) {
    const unsigned G = gridDim.x * gridDim.y * gridDim.z;
    unsigned sum, cnt, mine, sp = 0u;
    for (;;) {
        sum = 0u; cnt = 0u; mine = 0u;
#pragma unroll
        for (unsigned j = 0; j < 16; ++j) { const unsigned c = xb_ld(&bar[XB_XCNT(j)]); sum += c; cnt += (c > 0u) ? 1u : 0u; mine = (j == x) ? c : mine; }
        if (sum == G) break;
        __builtin_amdgcn_s_sleep(1);
        if ((++sp & 255u) == 0u) { if (xb_ld(&bar[XB_TMO])) break; if (sp > XB_SPIN_CAP) { atomicAdd(&bar[XB_TMO], 1u); break; } }
    }
    nloc = mine > 0u ? mine : 1u; nx = cnt > 0u ? cnt : 1u;
}
DEV void xcd_barrier(const XcdBarrier& b, int tid) {
    asm volatile("s_waitcnt vmcnt(0)" ::: "memory");
    __syncthreads();
    if (tid == 0) {
        unsigned* bar = b.bar;
        __builtin_amdgcn_s_waitcnt(0);
        unsigned nloc = b.st[0], nx = b.st[1];
        if (nloc == 0u) { xcd_barrier_complete(bar, b.x, nloc, nx); b.st[0] = nloc; b.st[1] = nx; }
        const unsigned old = xb_add(&bar[XB_XSUB(b.x)], 1u);
        const unsigned gen = old / nloc;
        if (old + 1u == (gen + 1u) * nloc) {
            __builtin_amdgcn_fence(__ATOMIC_RELEASE, "agent");
            asm volatile("s_waitcnt vmcnt(0)" ::: "memory");
            (void)xb_add(&bar[XB_TOP], 1u);
        }
        const unsigned tgt = (gen + 1u) * nx;
        XB_SPIN(xb_ld(&bar[XB_TOP]) < tgt, bar);
        __builtin_amdgcn_fence(__ATOMIC_ACQUIRE, "agent");
        asm volatile("s_waitcnt vmcnt(0)" ::: "memory");
    }
    __syncthreads();
}

struct MArgs { const float* in[21]; float* x; unsigned char* ws; int single, ph_lo, ph_hi, pad; };
namespace cg = cooperative_groups;
__global__ void __launch_bounds__(NTHR, 2) mega(MArgs a) {
    extern __shared__ __attribute__((aligned(16))) unsigned char lds_raw[];
    LAS unsigned char* lds = (LAS unsigned char*)lds_raw;
    unsigned char* ws = a.ws; float* x = a.x;
    bf16* XB = (bf16*)(ws + WS_XB); float* SSQ = (float*)(ws + WS_SSQ);
    bf16* WIN_ = (bf16*)(ws + WS_WIN); bf16* WOUT = (bf16*)(ws + WS_WOUT); bf16* WUP = (bf16*)(ws + WS_WUP); bf16* WDN = (bf16*)(ws + WS_WDN); bf16* WKVb = (bf16*)(ws + WS_WKV);
    bf16* WC1K = (bf16*)(ws + WS_WKV + 3 * MiB); bf16* WC1V = (bf16*)(ws + WS_WKV + 4 * MiB);
    bf16* W1IN = (bf16*)(ws + WS_KV + 16 * MiB); bf16* W1OUT = (bf16*)(ws + WS_KV + 24 * MiB); bf16* W1UP = (bf16*)(ws + WS_KV + 26 * MiB); bf16* W1DN = (bf16*)(ws + WS_KV + 34 * MiB);
    bf16* PROJ = (bf16*)(ws + WS_PROJ); bf16* KV = (bf16*)(ws + WS_KV); float* GATES = (float*)(ws + WS_GATES); bf16* CMP = (bf16*)(ws + WS_CMP);
    bf16* HIDC = (bf16*)(ws + WS_BIG + 64 * MiB);
    float* HST = (float*)(ws + WS_KV); float* HAUX = (float*)(ws + WS_KV + 49 * MiB); float* BSEG = (float*)(ws + WS_MISC); float* CBIAS = (float*)(ws + WS_MISC + 256 * 1024);
    const int G = gridDim.x, c = blockIdx.x, ngw = G * NWAVES;
    const int wave_s = __builtin_amdgcn_readfirstlane((int)threadIdx.x >> 6);
#define TID unsigned m1_ = ~0u; asm volatile("" : "+s"(m1_)); int tid = wave_s * 64 + (int)__builtin_amdgcn_mbcnt_hi(m1_, __builtin_amdgcn_mbcnt_lo(m1_, 0u)); asm volatile("" : "+v"(tid)); const int lane = tid & 63, gw = c * NWAVES + (tid >> 6); (void)lane; (void)gw
    volatile LAS unsigned* MISCW = (volatile LAS unsigned*)(lds + 131072 + 64);
    { const int t0_ = threadIdx.x; if (t0_ < 4) MISCW[t0_] = 0u; }
    __syncthreads();
    XcdBarrier xbar; xbar.bar = (unsigned*)(ws + WS_CTL) + 4096; xbar.x = 0; xbar.st = nullptr;
    if (MK_SINGLE || a.single) xbar = xcd_barrier_post((unsigned*)(ws + WS_CTL) + 4096, MISCW, (int)threadIdx.x);
    if (a.pad == 0x7fffffff) cg::this_grid().sync();
    int ph = 0; (void)ph;
#if MK_SINGLE
#define RUN true
#define SYNC do { TID; xcd_barrier(xbar, tid); if (PROBE & 64) xcd_barrier(xbar, tid); } while (0)
#else
#define RUN (a.ph_lo <= ph && ph < a.ph_hi)
#define SYNC do { if (a.single) { TID; xcd_barrier(xbar, tid); if (PROBE & 64) xcd_barrier(xbar, tid); } ++ph; } while (0)
#endif
#define BW(wsoff, xoff) ((bf16*)(b ? (unsigned char*)x + (xoff) * MiB : ws + (wsoff)))
#define CONV_MLP(layer) do { misc::conv_w(lds, a.in[18] + (size_t)(layer) * D * FF, a.in[17] + (layer) * D, WUP, D, FF, FF, c, G, tid); \
        misc::conv_w(lds, a.in[19] + (size_t)(layer) * FF * D, nullptr, WDN, FF, D, D, c, G, tid); } while (0)
    if (RUN) { TID;
        misc::prep_rows(a.in[0], XB, SSQ, gw, ngw, lane);
        for (int i = c * NTHR + tid; i < 16 * KVW / 2; i += G * NTHR) ((unsigned*)(KV + (size_t)T * KVW))[i] = 0u;
        if (c >= G - 32) misc::cmp_bias_part(a.in[8], a.in[9], a.in[11], a.in[12], CBIAS + 1024, c - (G - 32), tid);
    }
    if (RUN) { TID;
        misc::conv_w(lds, a.in[2], a.in[1], WIN_, D, 4096, 4096, c, G, tid);
    }
#pragma unroll 1
    for (int l = 0; l < 2; ++l) {
        const bf16* wIN = l ? W1IN : WIN_; const bf16* wOUT = l ? W1OUT : WOUT; const bf16* wUP = l ? W1UP : WUP; const bf16* wDN = l ? W1DN : WDN;
        SYNC;
        if (RUN && l == 0 && (c & 1)) { TID;
            misc::conv_w(lds, a.in[4], nullptr, WOUT, D, D, D, c >> 1, G >> 1, tid);
            misc::conv_w(lds, a.in[18], a.in[17], WUP, D, FF, FF, c >> 1, G >> 1, tid);
            misc::conv_w(lds, a.in[19], nullptr, WDN, FF, D, D, c >> 1, G >> 1, tid); }
        if (RUN) for (int rep = 0; rep < ((PROBE & 2) ? 2 : 1); ++rep) { TID; pg8::Sched S; S.init(XB, D, wIN, T, 4096, D, G, c); EpiRowBf16 E{PROJ, SSQ, 4096, ((PROBE & 256) && rep == 0) ? 2 : 0}; pg8::gemm_phase<EpiRowBf16, pg8::Sched, false>(lds, S, E, tid); }
        SYNC;
        if (RUN) for (int rep = ((PROBE & 128) ? 0 : 1); rep < 2; ++rep) { TID; hg::pass1(lds, PROJ, HST, BSEG, HAUX, a.in[5], l, c, G, tid, rep != 0); __syncthreads(); }
        SYNC;
        if (RUN) { TID; hg::scan(HST, BSEG, c * NTHR + tid, G * NTHR); }
        SYNC;
        if (RUN) for (int rep = ((PROBE & 32) ? 0 : 1); rep < 2; ++rep) { TID; hg::pass2(lds, PROJ, HST, HAUX, a.in[3] + l * 128, c, G, tid, rep ? PROJ : (bf16*)(ws + WS_KV + 16 * MiB), rep ? 4096 : 1024); __syncthreads(); }
        SYNC;
        if (RUN) for (int rep = ((PROBE & 16) ? 0 : 1); rep < 2; ++rep) { TID; pg8::Sched S; S.init(PROJ, 4096, wOUT, T, D, D, G, c); EpiResidual E{XB, SSQ, rep ? 1.0f : 0.0f, 0}; pg8::gemm_phase(lds, S, E, tid); }
        SYNC;
        if (RUN && l == 0 && (c & 1)) { TID;
            misc::conv_w(lds, a.in[18] + (size_t)D * FF, a.in[17] + D, W1UP, D, FF, FF, c >> 1, G >> 1, tid);
            misc::conv_w(lds, a.in[19] + (size_t)FF * D, nullptr, W1DN, FF, D, D, c >> 1, G >> 1, tid); }
        if (RUN && l == 1 && (c & 1)) { TID; misc::conv_w(lds, a.in[18] + (size_t)2 * D * FF, a.in[17] + 2 * D, WUP, D, FF, FF, c >> 1, G >> 1, tid); }
        if (RUN) for (int rep = 0; rep < ((PROBE & 2) ? 2 : 1); ++rep) { TID; pg8::Sched S; S.init(XB, D, wUP, T, FF, D, G, c); EpiRowBf16 E{PROJ, SSQ, FF, ((PROBE & 256) && rep == 0) ? 3 : 1}; pg8::gemm_phase<EpiRowBf16, pg8::Sched, false>(lds, S, E, tid); }
        SYNC;
        if (RUN && l == 0 && (c & 1)) { TID;
            misc::conv_w(lds, a.in[2] + (size_t)D * 4096, a.in[1] + D, W1IN, D, 4096, 4096, c >> 1, G >> 1, tid);
            misc::conv_w(lds, a.in[4] + (size_t)D * D, nullptr, W1OUT, D, D, D, c >> 1, G >> 1, tid);
            misc::conv_w(lds, a.in[7], a.in[6], WKVb, D, KVW, KVW, c >> 1, G >> 1, tid);
            misc::conv_w(lds, a.in[9], nullptr, WC1K, 2048, 256, 256, c >> 1, G >> 1, tid);
            misc::conv_w(lds, a.in[12], nullptr, WC1V, 2048, 256, 256, c >> 1, G >> 1, tid); }
        if (RUN) for (int rep = ((PROBE & 16) ? 0 : 1); rep < 2; ++rep) { TID; pg8::Sched S; S.init(PROJ, FF, wDN, T, D, FF, G, c); EpiResidual E{XB, SSQ, rep ? 1.0f : 0.0f, 0}; pg8::gemm_phase(lds, S, E, tid); }
        if (l == 1) SYNC;
    }
    if (RUN) for (int rep = 0; rep < ((PROBE & 2) ? 2 : 1); ++rep) { TID; pg8::Sched S; S.init(XB, D, WKVb, T, KVW, D, G, c); EpiRowBf16 E{KV, SSQ, KVW, 0}; pg8::gemm_phase<EpiRowBf16, pg8::Sched, false>(lds, S, E, tid);
        if (rep == 0 && c >= 128) {
            if (c == G - 1) misc::cmp_bias_sum(CBIAS + 1024, CBIAS, tid);
            misc::conv_w(lds, a.in[15], a.in[14], WIN_, D, BIN, BINP, c - 128, G - 128, tid);
            misc::conv_w(lds, a.in[16], nullptr, WOUT, D, D, D, c - 128, G - 128, tid);
            misc::conv_w(lds, a.in[19] + (size_t)2 * FF * D, nullptr, WDN, FF, D, D, c - 128, G - 128, tid); } }
    SYNC;
    if (RUN) { TID;
        if (c < 32) { SchedCmp S; S.init(KV, WC1K, WC1V, G, c); EpiCmp E{HIDC, CBIAS}; pg8::gemm_phase(lds, S, E, tid); }
        else { pg8::Sched S; S.init(XB, D, WIN_, T, D, D, G - 32, c - 32); EpiRowBf16 E{PROJ, SSQ, D, 0}; pg8::gemm_phase<EpiRowBf16, pg8::Sched, false>(lds, S, E, tid);
            for (int tile = c - 32; tile < T / 64; tile += G - 32) misc::gates_tile(lds, XB, WIN_ + (size_t)D * D, SSQ, GATES, tile, tid);
            if (c >= 64) { bf16* XW = (bf16*)x; __syncthreads();
                misc::conv_w(lds, a.in[15] + (size_t)D * BIN, a.in[14] + D, XW, D, BIN, BINP, c - 64, G - 64, tid);
                misc::conv_w(lds, a.in[16] + (size_t)D * D, nullptr, XW + 2 * MiB, D, D, D, c - 64, G - 64, tid);
                misc::conv_w(lds, a.in[18] + (size_t)3 * D * FF, a.in[17] + 3 * D, XW + 3 * MiB, D, FF, FF, c - 64, G - 64, tid);
                misc::conv_w(lds, a.in[19] + (size_t)3 * FF * D, nullptr, XW + 7 * MiB, FF, D, D, c - 64, G - 64, tid); } } }
    SYNC;
#pragma unroll 1
    for (int b = 0; b < 2; ++b) {
        if (b == 0) { if (RUN) { TID; misc::cmp2(lds, HIDC, a.in[10], a.in[13], CMP, c, G, tid); } }
        else if (RUN) for (int rep = 0; rep < ((PROBE & 2) ? 2 : 1); ++rep) { TID; pg8::Sched S; S.init(XB, D, (bf16*)x, T, D, D, G, c); EpiRowBf16 E{PROJ, SSQ, D, 0}; pg8::gemm_phase<EpiRowBf16, pg8::Sched, false>(lds, S, E, tid);
            if (rep == 0) { for (int tile = c; tile < T / 64; tile += G) misc::gates_tile(lds, XB, (bf16*)x + (size_t)D * D, SSQ, GATES, tile, tid); } }
        SYNC;
        if (RUN) { TID; if (PROBE & 1) { nsa::phase(lds, PROJ, GATES, KV, CMP, c, G, tid, PROJ + (size_t)T * D, (PROBE >> 12) & 15, (unsigned*)(ws + WS_CTL) + 12288 + 64 * b + 32); __syncthreads(); } nsa::phase(lds, PROJ, GATES, KV, CMP, c, G, tid, PROJ, 0, (unsigned*)(ws + WS_CTL) + 12288 + 64 * b); }
        SYNC;
        if (RUN) for (int rep = ((PROBE & 16) ? 0 : 1); rep < 2; ++rep) { TID; pg8::Sched S; S.init(PROJ, D, BW(WS_WOUT, 4), T, D, D, G, c); EpiResidual E{XB, SSQ, rep ? 1.0f : 0.0f, 0}; pg8::gemm_phase(lds, S, E, tid); }
        SYNC;
        if (RUN) for (int rep = 0; rep < ((PROBE & 2) ? 2 : 1); ++rep) { TID; pg8::Sched S; S.init(XB, D, BW(WS_WUP, 6), T, FF, D, G, c); EpiRowBf16 E{PROJ, SSQ, FF, ((PROBE & 256) && rep == 0) ? 3 : 1}; pg8::gemm_phase<EpiRowBf16, pg8::Sched, false>(lds, S, E, tid); }
        SYNC;
        if (RUN) for (int rep = ((PROBE & 16) ? 0 : 1); rep < 2; ++rep) { TID; pg8::Sched S; S.init(PROJ, FF, BW(WS_WDN, 14), T, D, FF, G, c); EpiResidual E{XB, SSQ, rep ? 1.0f : 0.0f, 0}; pg8::gemm_phase(lds, S, E, tid); }
        SYNC;
    }
    if (RUN) { TID; misc::final_norm(x, XB, a.in[20], SSQ, gw, ngw, lane); }
#undef RUN
#undef SYNC
}
constexpr int N_PHASES = 1 + 2 * 7 + 3 + 2 * 6;

#ifndef PROBE
#define PROBE 0
#endif
#ifndef MK_SINGLE
#define MK_SINGLE 1
#endif
extern "C" void kernel_launch(void* const* d_in, const int* in_sizes, int n_in, void* d_out, int out_size, void* d_ws, size_t ws_size, hipStream_t stream) {
    if (n_in != 21 || out_size != T * D || ws_size < WS_END) { fprintf(stderr, "kernel_launch: unexpected shapes n_in %d out %d ws %zu (need %zu)\n", n_in, out_size, ws_size, (size_t)WS_END); return; }
    static int grid = 0;
    if (grid == 0) {
        int dev = 0, cus = 0, per_cu = 0;
        if (hipGetDevice(&dev) != hipSuccess || hipDeviceGetAttribute(&cus, hipDeviceAttributeMultiprocessorCount, dev) != hipSuccess) { grid = -1; return; }
        if (hipFuncSetAttribute((const void*)mega, hipFuncAttributeMaxDynamicSharedMemorySize, LDS_BYTES) != hipSuccess) { fprintf(stderr, "kernel_launch: hipFuncSetAttribute failed\n"); grid = -1; return; }
        if (hipOccupancyMaxActiveBlocksPerMultiprocessor(&per_cu, (const void*)mega, NTHR, LDS_BYTES) != hipSuccess || per_cu < 1) { fprintf(stderr, "kernel_launch: occupancy query says %d blocks per CU\n", per_cu); per_cu = 1; }
        (void)hipGetLastError();
        grid = cus > 0 ? cus : 256;
    }
    if (grid < 0) return;
    MArgs a{};
    for (int i = 0; i < 21; ++i) a.in[i] = (const float*)d_in[i];
    a.x = (float*)d_out; a.ws = (unsigned char*)d_ws;
#if MK_SINGLE
    if (hipMemsetAsync((char*)d_ws + WS_CTL, 0, 65536, stream) != hipSuccess) { fprintf(stderr, "kernel_launch: memset failed\n"); return; }
    a.single = 1; a.ph_lo = 0; a.ph_hi = 1000;
    void* args[] = {&a};
    hipError_t e = hipLaunchCooperativeKernel((const void*)mega, dim3(grid), dim3(NTHR), args, LDS_BYTES, stream);
    if (e != hipSuccess) fprintf(stderr, "kernel_launch: cooperative launch failed: %s (grid %d)\n", hipGetErrorString(e), grid);
#else
    for (int ph = 0; ph <= 36; ++ph) { a.single = 0; a.ph_lo = ph; a.ph_hi = ph + 1; hipLaunchKernelGGL(mega, dim3(grid), dim3(NTHR), LDS_BYTES, stream, a); }
#endif
}
```
